# Optimizing an MI355X kernel written in HIP

```python
import jax, jax.numpy as jnp
from jax import lax
import numpy as np

D_MODEL = 1024
BATCH = 16
SEQ = 2048
DEPTH = 4

N_MIXERS = 2
EPS = 1e-6
ROPE_BASE = 10000.0

RET_HEADS = 4
RET_DK = 256
RET_DV = 512
RET_CHUNK = 128
RET_QK_W = RET_HEADS * RET_DK
RET_V_W = RET_HEADS * RET_DV
RET_IN_W = 2 * RET_QK_W + 2 * RET_V_W

MLA_HEADS = 16
MLA_Q_RANK = 256
MLA_KV_RANK = 128
MLA_NOPE = 128
MLA_ROPE = 64
MLA_V = 128
MLA_QK = MLA_NOPE + MLA_ROPE
MLA_V_W = MLA_HEADS * MLA_V
MLA_IN_W = MLA_Q_RANK + MLA_KV_RANK + MLA_ROPE + MLA_V_W
Q_BLOCK = 128

kernel_name = "hybrid_retention_mla_gated_trunk"


def _rms(x):
    xf = x.astype(jnp.float32)
    return xf * lax.rsqrt(jnp.mean(xf * xf, axis=-1, keepdims=True) + EPS)


def rmsnorm(x, g):
    return (_rms(x) * g.astype(jnp.float32)).astype(x.dtype)


def rope(x, positions):
    d = x.shape[-1]
    half = d // 2
    inv_freq = ROPE_BASE ** (-jnp.arange(half, dtype=jnp.float32) / half)
    ang = positions.astype(jnp.float32)[..., None] * inv_freq
    cos = jnp.cos(ang)[:, :, None, :]
    sin = jnp.sin(ang)[:, :, None, :]
    xf = x.astype(jnp.float32)
    x1, x2 = xf[..., :half], xf[..., half:]
    out = jnp.concatenate([x1 * cos - x2 * sin, x2 * cos + x1 * sin], axis=-1)
    return out.astype(x.dtype)


def retention_mixer(h, positions, w_in, gn, w_out):
    B, S, _ = h.shape
    H, C = RET_HEADS, RET_CHUNK
    nc = S // C
    proj = h @ w_in
    q, k, v, gate = jnp.split(proj, [RET_QK_W, 2 * RET_QK_W, 2 * RET_QK_W + RET_V_W], axis=-1)
    q = rope(q.reshape(B, S, H, RET_DK), positions)
    k = rope(k.reshape(B, S, H, RET_DK), positions) * (RET_DK ** -0.5)
    v = v.reshape(B, S, H, RET_DV)

    log_g = jnp.log(1.0 - 2.0 ** (-5.0 - jnp.arange(H, dtype=jnp.float32)))
    idx = jnp.arange(C, dtype=jnp.float32)
    diff = idx[:, None] - idx[None, :]
    dmask = jnp.where(diff[None] >= 0, jnp.exp(jnp.maximum(diff, 0.0)[None] * log_g[:, None, None]), 0.0)
    q_decay = jnp.exp((idx + 1.0)[:, None] * log_g[None, :])
    k_decay = jnp.exp((C - 1.0 - idx)[:, None] * log_g[None, :])
    chunk_decay = jnp.exp(C * log_g)

    qc = q.reshape(B, nc, C, H, RET_DK)
    kc = k.reshape(B, nc, C, H, RET_DK)
    vc = v.reshape(B, nc, C, H, RET_DV)

    s = jnp.einsum('bnihd,bnjhd->bnhij', qc, kc).astype(jnp.float32) * dmask[None, None]
    intra = jnp.einsum('bnhij,bnjhv->bnihv', s.astype(v.dtype), vc)

    def body(R, inp):
        q_n, k_n, v_n = inp
        cross = jnp.einsum('bihd,bhdv->bihv', q_n.astype(jnp.float32), R) * q_decay[None, :, :, None]
        kv = jnp.einsum('bjhd,bjhv->bhdv',
                        k_n.astype(jnp.float32) * k_decay[None, :, :, None],
                        v_n.astype(jnp.float32))
        R = R * chunk_decay[None, :, None, None] + kv
        return R, cross.astype(v_n.dtype)

    R0 = jnp.zeros((B, H, RET_DK, RET_DV), jnp.float32)
    xs = (qc.transpose(1, 0, 2, 3, 4), kc.transpose(1, 0, 2, 3, 4), vc.transpose(1, 0, 2, 3, 4))
    _, cross = lax.scan(body, R0, xs)
    o = (intra + cross.transpose(1, 0, 2, 3, 4)).reshape(B, S, H, RET_DV)

    o = (_rms(o).reshape(B, S, RET_V_W) * gn.astype(jnp.float32)).astype(h.dtype)
    return (o * jax.nn.silu(gate)) @ w_out


def causal_block_attention(q, k, v):
    B, S, H, dq = q.shape
    nb = S // Q_BLOCK
    scale = dq ** -0.5
    qb = q.reshape(B, nb, Q_BLOCK, H, dq).transpose(1, 0, 2, 3, 4)
    k_pos = jnp.arange(S)

    def one_block(args):
        q_blk, blk = args
        s = jnp.einsum('bqhd,bkhd->bhqk', q_blk, k).astype(jnp.float32) * scale
        q_pos = blk * Q_BLOCK + jnp.arange(Q_BLOCK)
        s = jnp.where(k_pos[None, :] <= q_pos[:, None], s, -1e30)
        p = jax.nn.softmax(s, axis=-1).astype(v.dtype)
        return jnp.einsum('bhqk,bkhv->bqhv', p, v)

    out = lax.map(one_block, (qb, jnp.arange(nb)))
    return out.transpose(1, 0, 2, 3, 4).reshape(B, S, H, v.shape[-1])


def mla_mixer(h, positions, w_in, q_norm, w_q_b, kv_norm, w_kv_b, w_out):
    B, S, _ = h.shape
    H = MLA_HEADS
    proj = h @ w_in
    q_lat, kv_lat, k_rope, gate = jnp.split(
        proj, [MLA_Q_RANK, MLA_Q_RANK + MLA_KV_RANK, MLA_Q_RANK + MLA_KV_RANK + MLA_ROPE], axis=-1)
    q = (rmsnorm(q_lat, q_norm) @ w_q_b).reshape(B, S, H, MLA_QK)
    q = jnp.concatenate([q[..., :MLA_NOPE], rope(q[..., MLA_NOPE:], positions)], axis=-1)
    kv = (rmsnorm(kv_lat, kv_norm) @ w_kv_b).reshape(B, S, H, MLA_NOPE + MLA_V)
    k_nope, v = kv[..., :MLA_NOPE], kv[..., MLA_NOPE:]
    k_rope = rope(k_rope[:, :, None, :], positions)
    k = jnp.concatenate([k_nope, jnp.broadcast_to(k_rope, (B, S, H, MLA_ROPE))], axis=-1)
    o = causal_block_attention(q, k, v).reshape(B, S, MLA_V_W)
    return (o * jax.nn.silu(gate)) @ w_out


def setup_inputs(seed: int = 0) -> dict:
    key = jax.random.key(seed)
    keys = iter(jax.random.split(key, 64))

    def w(shape, fan_in):
        return jax.random.normal(next(keys), shape, jnp.float32) * (fan_in ** -0.5)

    def gain(n):
        return 1.0 + 0.02 * jax.random.normal(next(keys), (n,), jnp.float32)

    x = jax.random.normal(next(keys), (BATCH, SEQ, D_MODEL), jnp.float32)
    offset = jax.random.randint(next(keys), (BATCH, 1), 0, 1024, dtype=jnp.int32)
    positions = (offset + jnp.arange(SEQ, dtype=jnp.int32)[None, :]).astype(jnp.int32)

    d = {"x": x, "positions": positions}
    for i in range(DEPTH):
        d[f"l{i}_norm"] = gain(D_MODEL)
        if i % N_MIXERS == 0:
            d[f"l{i}_ret_w_in"] = w((D_MODEL, RET_IN_W), D_MODEL)
            d[f"l{i}_ret_gn"] = gain(RET_V_W)
            d[f"l{i}_ret_w_out"] = w((RET_V_W, D_MODEL), RET_V_W)
        else:
            d[f"l{i}_mla_w_in"] = w((D_MODEL, MLA_IN_W), D_MODEL)
            d[f"l{i}_mla_q_norm"] = gain(MLA_Q_RANK)
            d[f"l{i}_mla_w_q_b"] = w((MLA_Q_RANK, MLA_HEADS * MLA_QK), MLA_Q_RANK)
            d[f"l{i}_mla_kv_norm"] = gain(MLA_KV_RANK)
            d[f"l{i}_mla_w_kv_b"] = w((MLA_KV_RANK, MLA_HEADS * (MLA_NOPE + MLA_V)), MLA_KV_RANK)
            d[f"l{i}_mla_w_out"] = w((MLA_V_W, D_MODEL), MLA_V_W)
    d["final_norm"] = gain(D_MODEL)
    return d


def reference(x, positions,
              l0_norm, l0_ret_w_in, l0_ret_gn, l0_ret_w_out,
              l1_norm, l1_mla_w_in, l1_mla_q_norm, l1_mla_w_q_b, l1_mla_kv_norm, l1_mla_w_kv_b, l1_mla_w_out,
              l2_norm, l2_ret_w_in, l2_ret_gn, l2_ret_w_out,
              l3_norm, l3_mla_w_in, l3_mla_q_norm, l3_mla_w_q_b, l3_mla_kv_norm, l3_mla_w_kv_b, l3_mla_w_out,
              final_norm):
    norms = [l0_norm, l1_norm, l2_norm, l3_norm]
    ret_params = [(l0_ret_w_in, l0_ret_gn, l0_ret_w_out),
                  (l2_ret_w_in, l2_ret_gn, l2_ret_w_out)]
    mla_params = [(l1_mla_w_in, l1_mla_q_norm, l1_mla_w_q_b, l1_mla_kv_norm, l1_mla_w_kv_b, l1_mla_w_out),
                  (l3_mla_w_in, l3_mla_q_norm, l3_mla_w_q_b, l3_mla_kv_norm, l3_mla_w_kv_b, l3_mla_w_out)]
    h = x
    for i in range(DEPTH):
        u = rmsnorm(h, norms[i])
        if i % N_MIXERS == 0:
            h = h + retention_mixer(u, positions, *ret_params[i // N_MIXERS])
        else:
            h = h + mla_mixer(u, positions, *mla_params[i // N_MIXERS])
    return rmsnorm(h, final_norm)
```

```cpp
#include <hip/hip_runtime.h>
#include <hip/hip_cooperative_groups.h>
#include <cstdio>
namespace cg = cooperative_groups;

#ifndef MULTI_LAUNCH
#define MULTI_LAUNCH 0
#endif

#ifndef PROBE_DUP
#define PROBE_DUP 0
#endif
#ifndef SCAN_SKIP
#define SCAN_SKIP 0
#endif
#ifndef EPI_MASK
#define EPI_MASK 127
#endif
#ifndef EN_GEMM
#define EN_GEMM 1
#endif
#ifndef EN_ATTN
#define EN_ATTN 1
#endif
#ifndef EN_SCAN
#define EN_SCAN 1
#endif
#define LAS __attribute__((address_space(3)))
#define DI __device__ __forceinline__
typedef unsigned short bf16_t;
typedef short bf16x8 __attribute__((ext_vector_type(8)));
typedef short s16x4 __attribute__((ext_vector_type(4)));
typedef float f32x4 __attribute__((ext_vector_type(4)));
typedef float f32x16 __attribute__((ext_vector_type(16)));
typedef unsigned u32x4 __attribute__((ext_vector_type(4)));
typedef unsigned u32x2 __attribute__((ext_vector_type(2)));

constexpr int TH = 16384;
constexpr int SEQ = 2048;
constexpr int DM = 1024;
constexpr int LDS_BYTES = 147456;
constexpr float EPS = 1e-6f;
constexpr float LOG2_1E4 = 13.287712379549449f;
constexpr float LOG2E = 1.4426950408889634f;
constexpr size_t MiB = (size_t)1 << 20;

constexpr size_t W_RET = 0;
constexpr size_t W_MLA = 32 * MiB;
constexpr size_t W_MLA_SZ = 12 * MiB + MiB / 2;
constexpr size_t O_HB = 57 * MiB;
constexpr size_t O_SSQH = 89 * MiB;
constexpr size_t O_G = 90 * MiB;
constexpr size_t O_RQ = 154 * MiB;
constexpr size_t O_RK = 186 * MiB;
constexpr size_t O_RKDT = 218 * MiB;
constexpr size_t O_RVT = 250 * MiB;
constexpr size_t O_SSQO = 314 * MiB;
constexpr size_t O_LAT = 154 * MiB;
constexpr size_t O_KROPE = 166 * MiB;
constexpr size_t O_SSQQ = 168 * MiB;
constexpr size_t O_SSQKV = 168 * MiB + MiB / 4;
constexpr size_t O_MQ = 169 * MiB;
constexpr size_t O_KN = 265 * MiB;
constexpr size_t O_MVT = 329 * MiB;
constexpr size_t WS_NEED = 393 * MiB;
constexpr size_t O_SSQH2 = 395 * MiB;
constexpr size_t O_BAR = 396 * MiB;
constexpr size_t O_DUMMY = 400 * MiB;

struct Params {
    const float* x; const int* pos;
    const float* lnorm[4];
    const float* ret_win[2]; const float* ret_gn[2]; const float* ret_wout[2];
    const float* mla_win[2]; const float* mla_qn[2]; const float* mla_wqb[2]; const float* mla_kvn[2]; const float* mla_wkvb[2]; const float* mla_wout[2];
    const float* fnorm;
    float* out; unsigned char* ws;
    int ph_lo, ph_hi;
};

DI unsigned pk2(float lo, float hi) {
    typedef __bf16 bf2 __attribute__((ext_vector_type(2)));
    typedef float f2 __attribute__((ext_vector_type(2)));
    f2 v = {lo, hi};
    bf2 b = __builtin_convertvector(v, bf2);
    return __builtin_bit_cast(unsigned, b);
}
DI float bflo(unsigned u) { return __uint_as_float(u << 16); }
DI float bfhi(unsigned u) { return __uint_as_float(u & 0xffff0000u); }
DI float fexp2(float x) { return __builtin_amdgcn_exp2f(x); }
DI void sincos_rev(float ang, float& s, float& c) {
    float rev = ang * 0.15915494309189535f;
    rev = __builtin_amdgcn_fractf(rev);
    s = __builtin_amdgcn_sinf(rev);
    c = __builtin_amdgcn_cosf(rev);
}
DI float silu(float x) { return x * __builtin_amdgcn_rcpf(1.0f + fexp2(-x * LOG2E)); }
DI float rstd_parts(const float* p, int nparts4, float invn) {
    float s = 0.f;
    for (int i = 0; i < nparts4; ++i) { f32x4 v = *(const f32x4*)(p + 4 * i); s += (v.x + v.y) + (v.z + v.w); }
    return __builtin_amdgcn_rsqf(s * invn + EPS);
}
DI u32x4 pack8(const f32x4& a, const f32x4& b, float sc) {
    u32x4 w; w.x = pk2(a[0] * sc, a[1] * sc); w.y = pk2(a[2] * sc, a[3] * sc); w.z = pk2(b[0] * sc, b[1] * sc); w.w = pk2(b[2] * sc, b[3] * sc); return w;
}
#define MFMA32(a, b, c) __builtin_amdgcn_mfma_f32_32x32x16_bf16((a), (b), (c), 0, 0, 0)
DI bf16x8 pack_step(const f32x16& x, int s) {
    u32x4 p;
    p.x = pk2(x[8 * s + 0], x[8 * s + 1]); p.y = pk2(x[8 * s + 2], x[8 * s + 3]); p.z = pk2(x[8 * s + 4], x[8 * s + 5]); p.w = pk2(x[8 * s + 6], x[8 * s + 7]);
    return __builtin_bit_cast(bf16x8, p);
}

namespace pg8 {
constexpr int BM = 256, BK = 64, HALF = 128, HTB = HALF * BK * 2, NXCD = 8, WGM = 8;
DI int lds_byte(int r, int c) { const int st = (r >> 4) * 2 + (c >> 5), rr = r & 15, cc = c & 31, ob = rr * 64 + cc * 2; return st * 1024 + (ob ^ (((ob >> 9) & 1) << 5)); }
DI void stage_rc(int b, int& R, int& C) { const int st = b / 1024, sb = b % 1024, swz = sb ^ (((sb >> 9) & 1) << 5); R = (st >> 1) * 16 + swz / 64; C = (st & 1) * 32 + (swz % 64) / 2; }
DI int perm32(int rho) { const int n = rho >> 4, i = rho & 15; return 8 * (i >> 2) + 4 * n + (i & 3); }
struct Unit { int pm, pn; };
struct StaticOrder {
    int nM, nN, nwg, G, c;
    DI void init(int nM_, int nN_, int G_, int c_) { nM = nM_; nN = nN_; nwg = nM * nN; G = G_; c = c_; }
    DI bool next(int i, Unit& u) const {
        const long L = (long)i * G + c; if (L >= nwg) return false;
        int wgid = (int)L; { const int q = nwg / NXCD, r = nwg % NXCD, xcd = wgid % NXCD, off = wgid / NXCD; wgid = (xcd < r ? xcd * (q + 1) : r * (q + 1) + (xcd - r) * q) + off; }
        const int nig = WGM * nN, gid = wgid / nig, fm = gid * WGM, gsz = (nM - fm) < WGM ? (nM - fm) : WGM;
        u.pm = fm + ((wgid % nig) % gsz); u.pn = (wgid % nig) / gsz; return true;
    }
};
}

enum { E_RETQG = 0, E_RETT, E_OUT, E_MLAIN, E_QB, E_KB, E_VB };
struct GemmD {
    const bf16_t* A; const bf16_t* Bt; int lda, ldb, K, nM, nN, bskip_from, bskip_add, epi;
    const int* pos;
    const float* ssq_in;
    float* ssq_out; float* ssq_out2;
    bf16_t* o0; bf16_t* o1; bf16_t* o2;
    const float* hin; float* hout;
    float lg2a, lg2b, lg2c, lg2d;
    const float* kscale;
};

typedef f32x4 AccT[2][2][4][2];

DI void rope_pair8(const f32x4& a0, const f32x4& a1, const f32x4& b0, const f32x4& b1, float rs, float posf, int i0, float fexp, float osc, u32x4& lo, u32x4& hi) {
#pragma unroll
    for (int e2 = 0; e2 < 4; ++e2) {
        float o0[2], o1[2];
#pragma unroll
        for (int t = 0; t < 2; ++t) {
            const int e = 2 * e2 + t;
            const float v0 = (e < 4 ? a0[e & 3] : a1[e & 3]) * rs, v1 = (e < 4 ? b0[e & 3] : b1[e & 3]) * rs;
            const float invf = fexp2(-(float)(i0 + e) * fexp);
            float sn, cs; sincos_rev(posf * invf, sn, cs);
            o0[t] = (v0 * cs - v1 * sn) * osc; o1[t] = (v1 * cs + v0 * sn) * osc;
        }
        lo[e2] = pk2(o0[0], o0[1]); hi[e2] = pk2(o1[0], o1[1]);
    }
}

DI void row_stats(const GemmD& g, int pm, int wr, int fr, int fq, bool p16, float invn, float (&rsr)[2][4], int (&posr)[2][4]) {
    f32x4 pv[2][4];
#pragma unroll
    for (int ai = 0; ai < 2; ++ai)
#pragma unroll
        for (int m = 0; m < 4; ++m) {
            const int row = pm * 256 + ai * 128 + wr * 64 + m * 16 + fr;
            pv[ai][m] = p16 ? *(const f32x4*)(g.ssq_in + (size_t)row * 16 + 4 * fq) : *(const f32x4*)(g.ssq_in + (size_t)row * 4);
            posr[ai][m] = g.pos[row];
        }
#pragma unroll
    for (int ai = 0; ai < 2; ++ai)
#pragma unroll
        for (int m = 0; m < 4; ++m) {
            float sm = (pv[ai][m].x + pv[ai][m].y) + (pv[ai][m].z + pv[ai][m].w);
            if (p16) { sm += __shfl_xor(sm, 16); sm += __shfl_xor(sm, 32); }
            rsr[ai][m] = __builtin_amdgcn_rsqf(sm * invn + EPS);
        }
}

DI void gemm_epilogue(const GemmD& g, const AccT& acc, const pg8::Unit& u, int wr, int wc, int fr_, int fq_) {
    const int pm = u.pm, pn = u.pn;
    int fr = fr_, fq = fq_;
    asm volatile("" : "+v"(fr), "+v"(fq));
    const int cw = 32 * wc + 8 * fq;
    float rsr[2][4]; int posr[2][4];
    if (((EPI_MASK >> E_RETQG) & 1) && g.epi == E_RETQG) {
        row_stats(g, pm, wr, fr, fq, true, 1.0f / 1024.0f, rsr, posr);
#pragma unroll
        for (int ai = 0; ai < 2; ++ai)
#pragma unroll
            for (int m = 0; m < 4; ++m) {
                const int row = pm * 256 + ai * 128 + wr * 64 + m * 16 + fr;
                const float rs = rsr[ai][m];
                if (pn < 8) {
                    const int head = pn & 3; const bool isk = pn >= 4;
                    bf16_t* dst = isk ? g.o1 + (size_t)row * 1024 + head * 256 + cw
                                      : g.o0 + ((((size_t)(row >> 5) * 4 + head) * 16 + (cw >> 4)) * 512 + (((cw >> 3) & 1) * 32 + (row & 31)) * 8);
                    const int dst_hi = isk ? 128 : 8 * 512;
                    u32x4 lo, hi;
                    rope_pair8(acc[ai][0][m][0], acc[ai][0][m][1], acc[ai][1][m][0], acc[ai][1][m][1], rs, (float)posr[ai][m], cw, LOG2_1E4 / 128.0f, isk ? 0.0625f : 1.0f, lo, hi);
                    *(u32x4*)dst = lo; *(u32x4*)(dst + dst_hi) = hi;
                } else {
                    bf16_t* dst = g.o2 + (size_t)row * 2048 + (pn - 8) * 256 + cw;
#pragma unroll
                    for (int bj = 0; bj < 2; ++bj) *(u32x4*)(dst + bj * 128) = pack8(acc[ai][bj][m][0], acc[ai][bj][m][1], rs);
                }
            }
    } else if (((EPI_MASK >> E_RETT) & 1) && g.epi == E_RETT) {
        const float lg2 = pm == 0 ? g.lg2a : pm == 1 ? g.lg2b : pm == 2 ? g.lg2c : g.lg2d;
#pragma unroll
        for (int bj = 0; bj < 2; ++bj) {
            const int tok0 = pn * 256 + bj * 128 + cw;
            float rs[8], pf[8];
#pragma unroll
            for (int e = 0; e < 8; ++e) { rs[e] = g.ssq_in[(size_t)(tok0 + e) * 16 + fr]; pf[e] = (float)g.pos[tok0 + e]; }
#pragma unroll
            for (int e = 0; e < 8; ++e) {
                float sm = rs[e];
                sm += __shfl_xor(sm, 1); sm += __shfl_xor(sm, 2); sm += __shfl_xor(sm, 4); sm += __shfl_xor(sm, 8);
                rs[e] = __builtin_amdgcn_rsqf(sm * (1.0f / 1024.0f) + EPS) * fexp2((float)(127 - ((tok0 + e) & 127)) * lg2) * 0.0625f;
            }
#pragma unroll
            for (int m = 0; m < 4; ++m) {
                const int i = wr * 64 + m * 16 + fr;
                const float invf = fexp2(-(float)i * (LOG2_1E4 / 128.0f));
                u32x4 lo, hi;
#pragma unroll
                for (int e2 = 0; e2 < 4; ++e2) {
                    float o0[2], o1[2];
#pragma unroll
                    for (int t = 0; t < 2; ++t) {
                        const int e = 2 * e2 + t;
                        const float v0 = acc[0][bj][m][e >> 2][e & 3] * rs[e], v1 = acc[1][bj][m][e >> 2][e & 3] * rs[e];
                        float sn, cs; sincos_rev(pf[e] * invf, sn, cs);
                        o0[t] = v0 * cs - v1 * sn; o1[t] = v1 * cs + v0 * sn;
                    }
                    lo[e2] = pk2(o0[0], o0[1]); hi[e2] = pk2(o1[0], o1[1]);
                    __builtin_amdgcn_sched_barrier(0);
                }
                *(u32x4*)(g.o0 + (size_t)(pm * 256 + i) * TH + tok0) = lo;
                *(u32x4*)(g.o0 + (size_t)(pm * 256 + 128 + i) * TH + tok0) = hi;
            }
        }
    } else if (((EPI_MASK >> E_VB) & 1) && g.epi == E_VB) {
        const bool hstat = g.lg2a > 0.f;
#pragma unroll
        for (int bj = 0; bj < 2; ++bj) {
            const int tok0 = pn * 256 + bj * 128 + cw;
            float rs[8];
#pragma unroll
            for (int e = 0; e < 8; ++e) rs[e] = hstat ? g.ssq_in[(size_t)(tok0 + e) * 16 + fr] : g.ssq_in[(size_t)(tok0 + e) * 4 + (fr & 3)];
#pragma unroll
            for (int e = 0; e < 8; ++e) {
                float sm = rs[e];
                sm += __shfl_xor(sm, 1); sm += __shfl_xor(sm, 2);
                if (hstat) { sm += __shfl_xor(sm, 4); sm += __shfl_xor(sm, 8); }
                rs[e] = __builtin_amdgcn_rsqf(sm * (hstat ? 1.0f / 1024.0f : 1.0f / 128.0f) + EPS);
            }
#pragma unroll
            for (int ai = 0; ai < 2; ++ai)
#pragma unroll
                for (int m = 0; m < 4; ++m) {
                    const int frow = pm * 256 + ai * 128 + wr * 64 + m * 16 + fr;
                    const f32x4 a = acc[ai][bj][m][0], b = acc[ai][bj][m][1];
                    u32x4 w; w.x = pk2(a[0] * rs[0], a[1] * rs[1]); w.y = pk2(a[2] * rs[2], a[3] * rs[3]);
                    w.z = pk2(b[0] * rs[4], b[1] * rs[5]); w.w = pk2(b[2] * rs[6], b[3] * rs[7]);
                    *(u32x4*)(g.o1 + (size_t)frow * TH + tok0) = w;
                }
        }
    } else if (((EPI_MASK >> E_OUT) & 1) && g.epi == E_OUT) {
#pragma unroll
        for (int ai = 0; ai < 2; ++ai) {
            f32x4 hv[4][2][2];
#pragma unroll
            for (int m = 0; m < 4; ++m)
#pragma unroll
                for (int bj = 0; bj < 2; ++bj) {
                    const size_t off = (size_t)(pm * 256 + ai * 128 + wr * 64 + m * 16 + fr) * 1024 + pn * 256 + bj * 128 + cw;
                    hv[m][bj][0] = *(const f32x4*)(g.hin + off); hv[m][bj][1] = *(const f32x4*)(g.hin + off + 4);
                }
#pragma unroll
            for (int m = 0; m < 4; ++m) {
                const int row = pm * 256 + ai * 128 + wr * 64 + m * 16 + fr;
                float ss = 0.f;
#pragma unroll
                for (int bj = 0; bj < 2; ++bj) {
                    const size_t off = (size_t)row * 1024 + pn * 256 + bj * 128 + cw;
                    const f32x4 h0 = hv[m][bj][0] + acc[ai][bj][m][0], h1 = hv[m][bj][1] + acc[ai][bj][m][1];
                    *(f32x4*)(g.hout + off) = h0; *(f32x4*)(g.hout + off + 4) = h1;
                    if (g.o0) *(u32x4*)(g.o0 + off) = pack8(h0, h1, 1.0f);
                    ss += (h0.x * h0.x + h0.y * h0.y) + (h0.z * h0.z + h0.w * h0.w) + (h1.x * h1.x + h1.y * h1.y) + (h1.z * h1.z + h1.w * h1.w);
                }
                ss += __shfl_xor(ss, 16); ss += __shfl_xor(ss, 32);
                if (fq == 0) g.ssq_out[(size_t)row * 16 + pn * 4 + wc] = ss;
            }
        }
    } else if (((EPI_MASK >> E_MLAIN) & 1) && g.epi == E_MLAIN) {
        row_stats(g, pm, wr, fr, fq, true, 1.0f / 1024.0f, rsr, posr);
#pragma unroll
        for (int ai = 0; ai < 2; ++ai)
#pragma unroll
            for (int m = 0; m < 4; ++m) {
                const int row = pm * 256 + ai * 128 + wr * 64 + m * 16 + fr;
                const float rs = rsr[ai][m];
                if (pn == 0) {
                    float ss = 0.f;
#pragma unroll
                    for (int bj = 0; bj < 2; ++bj) {
                        const f32x4 a = acc[ai][bj][m][0] * rs, b = acc[ai][bj][m][1] * rs;
                        *(u32x4*)(g.o0 + (size_t)row * 384 + bj * 128 + cw) = pack8(a, b, 1.0f);
                        ss += (a.x * a.x + a.y * a.y) + (a.z * a.z + a.w * a.w) + (b.x * b.x + b.y * b.y) + (b.z * b.z + b.w * b.w);
                    }
                    ss += __shfl_xor(ss, 16); ss += __shfl_xor(ss, 32);
                    if (fq == 0) g.ssq_out[(size_t)row * 4 + wc] = ss;
                } else if (pn == 1) {
                    float ss = 0.f;
                    if (wc == 0) {
                        u32x4 lo, hi;
                        rope_pair8(acc[ai][0][m][0], acc[ai][0][m][1], acc[ai][1][m][0], acc[ai][1][m][1], rs, (float)posr[ai][m], 8 * fq, LOG2_1E4 / 32.0f, 1.0f, lo, hi);
                        *(u32x4*)(g.o1 + (size_t)row * 64 + 8 * fq) = lo; *(u32x4*)(g.o1 + (size_t)row * 64 + 32 + 8 * fq) = hi;
                    } else {
                        {
                            const f32x4 a = acc[ai][0][m][0] * rs, b = acc[ai][0][m][1] * rs;
                            *(u32x4*)(g.o0 + (size_t)row * 384 + 256 + cw - 32) = pack8(a, b, 1.0f);
                            ss += (a.x * a.x + a.y * a.y) + (a.z * a.z + a.w * a.w) + (b.x * b.x + b.y * b.y) + (b.z * b.z + b.w * b.w);
                        }
                        if (wc == 1) {
                            const f32x4 a = acc[ai][1][m][0] * rs, b = acc[ai][1][m][1] * rs;
                            *(u32x4*)(g.o0 + (size_t)row * 384 + 256 + 96 + 8 * fq) = pack8(a, b, 1.0f);
                            ss += (a.x * a.x + a.y * a.y) + (a.z * a.z + a.w * a.w) + (b.x * b.x + b.y * b.y) + (b.z * b.z + b.w * b.w);
                        }
                    }
                    ss += __shfl_xor(ss, 16); ss += __shfl_xor(ss, 32);
                    if (fq == 0) g.ssq_out2[(size_t)row * 4 + wc] = ss;
                } else {
                    bf16_t* dst = g.o2 + (size_t)row * 2048 + (pn - 2) * 256 + cw;
#pragma unroll
                    for (int bj = 0; bj < 2; ++bj) *(u32x4*)(dst + bj * 128) = pack8(acc[ai][bj][m][0], acc[ai][bj][m][1], rs);
                }
            }
    } else if (((EPI_MASK >> E_QB) & 1) && g.epi == E_QB) {
        row_stats(g, pm, wr, fr, fq, false, 1.0f / 256.0f, rsr, posr);
        const float qscale = 0.07216878364870322f * LOG2E;
#pragma unroll
        for (int ai = 0; ai < 2; ++ai)
#pragma unroll
            for (int m = 0; m < 4; ++m) {
                const int row = pm * 256 + ai * 128 + wr * 64 + m * 16 + fr;
                const float rs = rsr[ai][m] * qscale;
                if (pn < 8) {
#pragma unroll
                    for (int bj = 0; bj < 2; ++bj)
                        *(u32x4*)(g.o0 + ((size_t)row * 16 + 2 * pn + bj) * 192 + cw) = pack8(acc[ai][bj][m][0], acc[ai][bj][m][1], rs);
                } else {
                    const int head = 4 * (pn - 8) + wc;
                    u32x4 lo, hi;
                    rope_pair8(acc[ai][0][m][0], acc[ai][0][m][1], acc[ai][1][m][0], acc[ai][1][m][1], rs, (float)posr[ai][m], 8 * fq, LOG2_1E4 / 32.0f, 1.0f, lo, hi);
                    bf16_t* dst = g.o0 + ((size_t)row * 16 + head) * 192 + 128 + 8 * fq;
                    *(u32x4*)dst = lo; *(u32x4*)(dst + 32) = hi;
                }
            }
    } else if (((EPI_MASK >> E_KB) & 1) && g.epi == E_KB) {
        row_stats(g, pm, wr, fr, fq, false, 1.0f / 128.0f, rsr, posr);
#pragma unroll
        for (int ai = 0; ai < 2; ++ai)
#pragma unroll
            for (int m = 0; m < 4; ++m) {
                const int row = pm * 256 + ai * 128 + wr * 64 + m * 16 + fr;
                const float rs = rsr[ai][m];
#pragma unroll
                for (int bj = 0; bj < 2; ++bj)
                    *(u32x4*)(g.o0 + ((size_t)row * 16 + 2 * pn + bj) * 128 + cw) = pack8(acc[ai][bj][m][0], acc[ai][bj][m][1], rs);
            }
    }
}

DI void gemm_phase(LAS unsigned char* lds, const GemmD& g, int tid0) {
    using namespace pg8;
    const int tid = tid0, wid = __builtin_amdgcn_readfirstlane(tid >> 6), lane = tid & 63, wr = wid >> 2, wc = wid & 3, fr = lane & 15, fq = lane >> 4;
    const int K = g.K, nt = K / BK;
    StaticOrder S; S.init(g.nM, g.nN, (int)gridDim.x, (int)blockIdx.x);
    unsigned voffA, voffB;
    { int R, C; stage_rc(tid * 16, R, C); const int Rb = (R & ~31) + perm32(R & 31);
      voffA = (unsigned)(R * g.lda + C) * 2u; voffB = (unsigned)(Rb * g.ldb + C) * 2u; }
    const size_t pvoffA = (size_t)64 * g.lda * 2, pvoffB = (size_t)64 * g.ldb * 2;
    const size_t kstep = (size_t)(BK * 2);
    const size_t hstepA = (size_t)HALF * g.lda * 2, hstepB = (size_t)HALF * g.ldb * 2;
    const size_t tstepA = 2 * hstepA, tstepB = 2 * hstepB;
    const unsigned ldsw = (unsigned)wid * 1024u;
    const int aoff = lds_byte(wr * 64 + fr, fq * 8), boff = lds_byte(wc * 32 + fr, fq * 8);
#define PG8_SA(b, h) (((b) * 2 + (h)) * HTB)
#define PG8_SB(b, h) ((4 + (b) * 2 + (h)) * HTB)
#define PG8_STAGE(bufoff, gbase, voff) do { _Pragma("unroll") for (int _i = 0; _i < 2; ++_i) \
        __builtin_amdgcn_global_load_lds((const unsigned*)((const char*)(gbase) + _i * p##voff + voff), (LAS unsigned*)(lds + (bufoff) + ldsw + _i * 8192), 16, 0, 0); } while (0)
#define PG8_LDA(dst, b, h) do { _Pragma("unroll") for (int m = 0; m < 4; ++m) _Pragma("unroll") for (int k = 0; k < 2; ++k) dst[m][k] = *(const LAS bf16x8*)(lds + PG8_SA(b, h) + aoff + m * 2048 + k * 1024); } while (0)
#define PG8_LDB(dst, b, h) do { _Pragma("unroll") for (int n = 0; n < 2; ++n) _Pragma("unroll") for (int k = 0; k < 2; ++k) dst[n][k] = *(const LAS bf16x8*)(lds + PG8_SB(b, h) + boff + n * 2048 + k * 1024); } while (0)
#define PG8_MMA(ai, bj, At, Bt) do { __builtin_amdgcn_s_setprio(1); _Pragma("unroll") for (int m = 0; m < 4; ++m) _Pragma("unroll") for (int n = 0; n < 2; ++n) _Pragma("unroll") for (int k = 0; k < 2; ++k) \
        acc[ai][bj][m][n] = __builtin_amdgcn_mfma_f32_16x16x32_bf16(Bt[n][k], At[m][k], acc[ai][bj][m][n], 0, 0, 0); __builtin_amdgcn_s_setprio(0); } while (0)
#define PG8_WAIT_V(n) asm volatile("s_waitcnt vmcnt(" #n ")" ::: "memory")
#define PG8_WAIT_L(n) asm volatile("s_waitcnt lgkmcnt(" #n ")" ::: "memory")
#define PG8_BAR __builtin_amdgcn_s_barrier()
#define PG8_SCHED __builtin_amdgcn_sched_barrier(0)
#define PG8_BTILE(pn) ((pn) + ((pn) >= g.bskip_from ? g.bskip_add : 0))
    Unit cur, nxt; int ui = 0;
    if (!S.next(0, cur)) return;
    LAS float* ktab = (LAS float*)(lds + 131072 + wid * 2048);
#define PG8_KTAB(u_) do { if (g.kscale) { \
        _Pragma("unroll 1") for (int rr_ = 0; rr_ < 2; ++rr_) { const int rl_ = lane + 64 * rr_; \
            const int grow_ = (u_).pm * 256 + (rl_ >> 6) * 128 + wr * 64 + (rl_ & 63); float rprev_ = 0.f; \
            _Pragma("unroll") for (int h_ = 0; h_ < 4; ++h_) { const float* p_ = g.kscale + ((size_t)grow_ * 4 + h_) * 16; \
                const f32x4 a_ = *(const f32x4*)p_, b_ = *(const f32x4*)(p_ + 4), c_ = *(const f32x4*)(p_ + 8), d_ = *(const f32x4*)(p_ + 12); \
                const float sm_ = ((a_.x + a_.y) + (a_.z + a_.w)) + ((b_.x + b_.y) + (b_.z + b_.w)) + ((c_.x + c_.y) + (c_.z + c_.w)) + ((d_.x + d_.y) + (d_.z + d_.w)); \
                const float rc_ = __builtin_amdgcn_rsqf(sm_ * (1.0f / 512.0f) + EPS); \
                if (h_ > 0) ktab[(h_ - 1) * 128 + rl_] = rprev_ / rc_; \
                rprev_ = rc_; } \
            ktab[3 * 128 + rl_] = rprev_; } \
        asm volatile("s_waitcnt lgkmcnt(0)" ::: "memory"); } } while (0)
    PG8_KTAB(cur);
    AccT acc;
    float zz = 0.f; asm volatile("" : "+v"(zz));
#pragma unroll
    for (int a = 0; a < 2; ++a)
#pragma unroll
        for (int b = 0; b < 2; ++b)
#pragma unroll
            for (int m = 0; m < 4; ++m)
#pragma unroll
                for (int n = 0; n < 2; ++n) acc[a][b][m][n] = (f32x4){zz, zz, zz, zz};
    bf16x8 At[4][2], B0[2][2], B1[2][2];
    const char* cA = (const char*)g.A + (size_t)cur.pm * tstepA; const char* cB = (const char*)g.Bt + (size_t)PG8_BTILE(cur.pn) * tstepB;
    PG8_STAGE(PG8_SB(0, 0), cB, voffB); PG8_STAGE(PG8_SA(0, 0), cA, voffA); PG8_STAGE(PG8_SB(0, 1), cB + hstepB, voffB); PG8_STAGE(PG8_SA(0, 1), cA + hstepA, voffA);
    if (wr == 1) PG8_BAR;
    PG8_WAIT_V(4); PG8_BAR;
    PG8_STAGE(PG8_SB(1, 0), cB + kstep, voffB); PG8_STAGE(PG8_SA(1, 0), cA + kstep, voffA); PG8_STAGE(PG8_SB(1, 1), cB + hstepB + kstep, voffB);
    PG8_WAIT_V(6); PG8_BAR;
    for (;;) {
        const bool has_next = S.next(ui + 1, nxt);
        const char* nA = has_next ? (const char*)g.A + (size_t)nxt.pm * tstepA : cA; const char* nB = has_next ? (const char*)g.Bt + (size_t)PG8_BTILE(nxt.pn) * tstepB : cB;
        const int seglen = g.kscale ? 8 : nt;
        for (int t0 = 0; t0 < nt; t0 += seglen) {
        if (g.kscale && t0 > 0) {
            float rt[2][4];
#pragma unroll
            for (int a = 0; a < 2; ++a)
#pragma unroll
                for (int m = 0; m < 4; ++m) rt[a][m] = ktab[((t0 >> 3) - 1) * 128 + a * 64 + m * 16 + fr];
            asm volatile("s_waitcnt lgkmcnt(0)" ::: "memory");
#pragma unroll
            for (int a = 0; a < 2; ++a)
#pragma unroll
                for (int b = 0; b < 2; ++b)
#pragma unroll
                    for (int m = 0; m < 4; ++m)
#pragma unroll
                        for (int n = 0; n < 2; ++n) acc[a][b][m][n] *= rt[a][m];
        }
        for (int t = t0; t < t0 + seglen; t += 2) {
            const bool last = (t == nt - 2);
            const char* a1 = cA + (size_t)(t + 1) * kstep;
            const char* a2 = last ? nA : cA + (size_t)(t + 2) * kstep; const char* b2 = last ? nB : cB + (size_t)(t + 2) * kstep;
            const char* a3 = a2 + kstep; const char* b3 = b2 + kstep;
            PG8_LDB(B0, 0, 0); PG8_SCHED; PG8_LDA(At, 0, 0); PG8_STAGE(PG8_SA(1, 1), a1 + hstepA, voffA);
            PG8_WAIT_L(8); PG8_BAR; PG8_WAIT_L(0); PG8_MMA(0, 0, At, B0); PG8_BAR; PG8_SCHED;
            PG8_LDB(B1, 0, 1); PG8_STAGE(PG8_SB(0, 0), b2, voffB);
            PG8_BAR; PG8_WAIT_L(0); PG8_MMA(0, 1, At, B1); PG8_BAR;
            PG8_LDA(At, 0, 1); PG8_STAGE(PG8_SA(0, 0), a2, voffA);
            PG8_BAR; PG8_WAIT_L(0); PG8_MMA(1, 0, At, B0); PG8_BAR; PG8_SCHED;
            PG8_STAGE(PG8_SB(0, 1), b2 + hstepB, voffB);
            PG8_WAIT_V(6); PG8_BAR; PG8_MMA(1, 1, At, B1); PG8_BAR;
            PG8_LDB(B0, 1, 0); PG8_SCHED; PG8_LDA(At, 1, 0); PG8_STAGE(PG8_SA(0, 1), a2 + hstepA, voffA);
            PG8_WAIT_L(8); PG8_BAR; PG8_WAIT_L(0); PG8_MMA(0, 0, At, B0); PG8_BAR; PG8_SCHED;
            PG8_LDB(B1, 1, 1); PG8_STAGE(PG8_SB(1, 0), b3, voffB);
            PG8_BAR; PG8_WAIT_L(0); PG8_MMA(0, 1, At, B1); PG8_BAR;
            PG8_LDA(At, 1, 1); PG8_STAGE(PG8_SA(1, 0), a3, voffA);
            PG8_BAR; PG8_WAIT_L(0); PG8_MMA(1, 0, At, B0); PG8_BAR; PG8_SCHED;
            PG8_STAGE(PG8_SB(1, 1), b3 + hstepB, voffB);
            PG8_WAIT_V(6); PG8_BAR; PG8_MMA(1, 1, At, B1); PG8_BAR;
        }
        }
        if (g.kscale) {
            float rt[2][4];
#pragma unroll
            for (int a = 0; a < 2; ++a)
#pragma unroll
                for (int m = 0; m < 4; ++m) rt[a][m] = ktab[3 * 128 + a * 64 + m * 16 + fr];
            asm volatile("s_waitcnt lgkmcnt(0)" ::: "memory");
#pragma unroll
            for (int a = 0; a < 2; ++a)
#pragma unroll
                for (int b = 0; b < 2; ++b)
#pragma unroll
                    for (int m = 0; m < 4; ++m)
#pragma unroll
                        for (int n = 0; n < 2; ++n) acc[a][b][m][n] *= rt[a][m];
        }
        gemm_epilogue(g, acc, cur, wr, wc, fr, fq);
        if (!has_next) break;
        PG8_KTAB(nxt);
        asm volatile("" : "+v"(zz));
#pragma unroll
        for (int a = 0; a < 2; ++a)
#pragma unroll
            for (int b = 0; b < 2; ++b)
#pragma unroll
                for (int m = 0; m < 4; ++m)
#pragma unroll
                    for (int n = 0; n < 2; ++n) acc[a][b][m][n] = (f32x4){zz, zz, zz, zz};
        cur = nxt; cA = nA; cB = nB; ++ui;
    }
    PG8_WAIT_V(0);
    if (wr == 0) PG8_BAR;
    PG8_BAR;
}

struct WJob { const float* W; const float* gain; bf16_t* dst; int K, Nsrc, Nout, Kout, koff, map; };
DI int src_col(int map, int n) {
    if (map == 0) return n;
    if (map == 1) {
        if (n < 256) return n;
        if (n < 512) { const int c = n - 256;
            if (c < 32) return 384 + c; if (c < 128) return 256 + (c - 32); if (c < 160) return 384 + 32 + (c - 128); if (c < 192) return 256 + 96 + (c - 160); return -1; }
        return 448 + (n - 512);
    }
    if (map == 2) {
        const int pn = n >> 8, c = n & 255;
        if (pn < 8) return (2 * pn + (c >> 7)) * 192 + (c & 127);
        const int cl = c & 127; return (4 * (pn - 8) + (cl >> 5)) * 192 + 128 + (cl & 31) + ((c >> 7) ? 32 : 0);
    }
    if (map == 3) return (n >> 7) * 256 + (n & 127);
    return (n >> 7) * 256 + 128 + (n & 127);
}
DI WJob get_job(const Params& P, int j) {
    WJob w; w.koff = 0; w.map = 0; w.gain = nullptr;
    if (j < 4) { const int l = j >> 1; unsigned char* base = P.ws + W_RET + (size_t)l * 16 * MiB;
        if ((j & 1) == 0) { w.W = P.ret_win[l]; w.gain = P.lnorm[2 * l]; w.dst = (bf16_t*)base; w.K = 1024; w.Nsrc = 6144; w.Nout = 6144; w.Kout = 1024; }
        else { w.W = P.ret_wout[l]; w.gain = P.ret_gn[l]; w.dst = (bf16_t*)(base + 12 * MiB); w.K = 2048; w.Nsrc = 1024; w.Nout = 1024; w.Kout = 2048; }
        return w; }
    const int jj = j - 4, l = jj / 5, k = jj % 5; unsigned char* base = P.ws + W_MLA + (size_t)l * W_MLA_SZ;
    if (k == 0) { w.W = P.mla_win[l]; w.gain = P.lnorm[2 * l + 1]; w.dst = (bf16_t*)base; w.K = 1024; w.Nsrc = 2496; w.Nout = 2560; w.Kout = 1024; w.map = 1; }
    else if (k == 1) { w.W = P.mla_wqb[l]; w.gain = P.mla_qn[l]; w.dst = (bf16_t*)(base + 5 * MiB); w.K = 256; w.Nsrc = 3072; w.Nout = 3072; w.Kout = 256; w.map = 2; }
    else if (k == 2) { w.W = P.mla_wkvb[l]; w.gain = P.mla_kvn[l]; w.dst = (bf16_t*)(base + 6 * MiB + MiB / 2); w.K = 128; w.Nsrc = 4096; w.Nout = 2048; w.Kout = 128; w.koff = 0; w.map = 3; }
    else if (k == 3) { w.W = P.mla_wkvb[l]; w.gain = P.mla_kvn[l]; w.dst = (bf16_t*)(base + 7 * MiB + MiB / 2); w.K = 128; w.Nsrc = 4096; w.Nout = 2048; w.Kout = 128; w.koff = 0; w.map = 4; }
    else { w.W = P.mla_wout[l]; w.dst = (bf16_t*)(base + 8 * MiB + MiB / 2); w.K = 2048; w.Nsrc = 1024; w.Nout = 1024; w.Kout = 2048; }
    return w;
}
DI void wprep_phase(LAS unsigned char* lds, const Params& P, int tid0) {
    const int tid = tid0, wid = tid >> 6, lane = tid & 63;
    LAS float* scr = (LAS float*)(lds + wid * 8704);
    constexpr int NJ = 14;
    constexpr int cnt[NJ] = {3072, 1024, 3072, 1024, 1280, 384, 128, 128, 1024, 1280, 384, 128, 128, 1024};
    constexpr int NTOT = 2 * (3072 + 1024) + 2 * (1280 + 384 + 128 + 128 + 1024);
    for (int it0 = blockIdx.x * 8; it0 < NTOT; it0 += gridDim.x * 8) {
        int it = it0 + wid, j = 0;
        const bool live = it < NTOT;
        if (live) {
#pragma unroll
            for (int q = 0; q < NJ - 1; ++q) if (j == q && it >= cnt[q]) { it -= cnt[q]; j = q + 1; }
        }
        j = __builtin_amdgcn_readfirstlane(j); it = __builtin_amdgcn_readfirstlane(it);
        WJob w = get_job(P, live ? j : 0);
        const int nblk = w.Nout / 32;
        const int kb = it / nblk, nb = it % nblk, k0 = 64 * kb, n0 = 32 * nb;
        if (live) {
            const int sc = src_col(w.map, n0 + (lane & 31));
#pragma unroll 8
            for (int i = 0; i < 32; ++i) {
                const int kk = 2 * i + (lane >> 5), ks = k0 + kk - w.koff;
                float v = 0.f;
                if (sc >= 0 && ks >= 0) { v = w.W[(size_t)ks * w.Nsrc + sc]; if (w.gain) v *= w.gain[ks]; }
                scr[kk * 33 + (lane & 31)] = v;
            }
        }
        __syncthreads();
        if (live) {
            const int c = lane & 7;
#pragma unroll
            for (int jn = 0; jn < 4; ++jn) { const int n = (lane >> 3) + 8 * jn; const LAS float* sp = scr + (8 * c) * 33 + n;
                u32x4 o; o.x = pk2(sp[0 * 33], sp[1 * 33]); o.y = pk2(sp[2 * 33], sp[3 * 33]); o.z = pk2(sp[4 * 33], sp[5 * 33]); o.w = pk2(sp[6 * 33], sp[7 * 33]);
                *(u32x4*)(w.dst + (size_t)(n0 + n) * w.Kout + k0 + 8 * c) = o; }
        }
        __syncthreads();
    }
}

DI void xprep_phase(const Params& P, int half, int tid0) {
    const int wid = tid0 >> 6, lane = tid0 & 63;
    const float* x = P.x + (size_t)half * TH * DM;
    bf16_t* hb = (bf16_t*)(P.ws + O_HB); float* ssq = (float*)(P.ws + (half ? O_SSQH2 : O_SSQH));
    const int rstep = gridDim.x * 8;
    for (int row = blockIdx.x * 8 + wid; row < TH; row += 2 * rstep) {
        const int row2 = row + rstep; const bool has2 = row2 < TH; const int r2 = has2 ? row2 : row;
        const f32x4* xr = (const f32x4*)(x + (size_t)row * DM) + lane; const f32x4* xr2 = (const f32x4*)(x + (size_t)r2 * DM) + lane;
        f32x4 v[4], v2[4];
#pragma unroll
        for (int j = 0; j < 4; ++j) { v[j] = xr[64 * j]; v2[j] = xr2[64 * j]; }
        float s = 0.f, s2 = 0.f;
#pragma unroll
        for (int j = 0; j < 4; ++j) { s += (v[j].x * v[j].x + v[j].y * v[j].y) + (v[j].z * v[j].z + v[j].w * v[j].w);
            s2 += (v2[j].x * v2[j].x + v2[j].y * v2[j].y) + (v2[j].z * v2[j].z + v2[j].w * v2[j].w);
            u32x2 o; o.x = pk2(v[j].x, v[j].y); o.y = pk2(v[j].z, v[j].w); *((u32x2*)(hb + (size_t)row * DM) + lane + 64 * j) = o; }
        if (has2) {
#pragma unroll
            for (int j = 0; j < 4; ++j) { u32x2 o; o.x = pk2(v2[j].x, v2[j].y); o.y = pk2(v2[j].z, v2[j].w); *((u32x2*)(hb + (size_t)r2 * DM) + lane + 64 * j) = o; }
        }
#pragma unroll
        for (int o = 1; o < 64; o <<= 1) { s += __shfl_xor(s, o); s2 += __shfl_xor(s2, o); }
        if (lane < 16) { ssq[(size_t)row * 16 + lane] = lane == 0 ? s : 0.f; if (has2) ssq[(size_t)r2 * 16 + lane] = lane == 0 ? s2 : 0.f; }
    }
}

DI void gnorm_phase(const Params& P, int tid0, bool dry) {
    bf16_t* G = (bf16_t*)(P.ws + O_G); bf16_t* Go = (bf16_t*)(P.ws + (dry ? O_DUMMY : O_G)); const float* ssqo = (const float*)(P.ws + O_SSQO);
    const size_t nvec = (size_t)TH * 2048 / 8;
    for (size_t v = (size_t)blockIdx.x * 512 + tid0; v < nvec; v += (size_t)gridDim.x * 512) {
        const int row = (int)(v >> 8), c = (int)(v & 255) * 8, head = c >> 9;
        const float rs = rstd_parts(ssqo + ((size_t)row * 4 + head) * 16, 4, 1.0f / 512.0f);
        u32x4 w = *(u32x4*)(G + (size_t)row * 2048 + c);
        w.x = pk2(bflo(w.x) * rs, bfhi(w.x) * rs); w.y = pk2(bflo(w.y) * rs, bfhi(w.y) * rs); w.z = pk2(bflo(w.z) * rs, bfhi(w.z) * rs); w.w = pk2(bflo(w.w) * rs, bfhi(w.w) * rs);
        *(u32x4*)(Go + (size_t)row * 2048 + c) = w;
    }
}
DI void final_phase(const Params& P, int half, int tid0, bool dry) {
    float* h = P.out + (size_t)half * TH * DM; float* ho = dry ? (float*)(P.ws + O_DUMMY) : h; const float* ssq = (const float*)(P.ws + O_SSQH);
    const int wid = tid0 >> 6, lane = tid0 & 63;
    f32x4 gn[4];
#pragma unroll
    for (int j = 0; j < 4; ++j) gn[j] = *((const f32x4*)P.fnorm + lane + 64 * j);
    const int rstep = gridDim.x * 8;
    for (int row = blockIdx.x * 8 + wid; row < TH; row += 2 * rstep) {
        const int row2 = row + rstep; const bool has2 = row2 < TH; const int r2 = has2 ? row2 : row;
        float sm = ssq[(size_t)row * 16 + (lane & 15)], sm2 = ssq[(size_t)r2 * 16 + (lane & 15)];
        const f32x4* xr = (const f32x4*)(h + (size_t)row * DM) + lane; const f32x4* xr2 = (const f32x4*)(h + (size_t)r2 * DM) + lane;
        f32x4 v[4], v2[4];
#pragma unroll
        for (int j = 0; j < 4; ++j) { v[j] = xr[64 * j]; v2[j] = xr2[64 * j]; }
        sm += __shfl_xor(sm, 1); sm += __shfl_xor(sm, 2); sm += __shfl_xor(sm, 4); sm += __shfl_xor(sm, 8);
        sm2 += __shfl_xor(sm2, 1); sm2 += __shfl_xor(sm2, 2); sm2 += __shfl_xor(sm2, 4); sm2 += __shfl_xor(sm2, 8);
        const float rs = __builtin_amdgcn_rsqf(sm * (1.0f / 1024.0f) + EPS), rs2 = __builtin_amdgcn_rsqf(sm2 * (1.0f / 1024.0f) + EPS);
        f32x4* yr = (f32x4*)(ho + (size_t)row * DM) + lane; f32x4* yr2 = (f32x4*)(ho + (size_t)r2 * DM) + lane;
#pragma unroll
        for (int j = 0; j < 4; ++j) yr[64 * j] = v[j] * rs * gn[j];
        if (has2) {
#pragma unroll
            for (int j = 0; j < 4; ++j) yr2[64 * j] = v2[j] * rs2 * gn[j];
        }
    }
}

DI void attn_phase(LAS unsigned char* lds, const Params& P, int tid0, bool dry) {
    const size_t gdelta = dry ? (O_DUMMY - O_G) / 2 : 0;
    const bf16_t* MQ = (const bf16_t*)(P.ws + O_MQ); const bf16_t* KN = (const bf16_t*)(P.ws + O_KN);
    const bf16_t* KR = (const bf16_t*)(P.ws + O_KROPE); const bf16_t* MVT = (const bf16_t*)(P.ws + O_MVT); bf16_t* G = (bf16_t*)(P.ws + O_G);
    const int tid = tid0, wid = __builtin_amdgcn_readfirstlane(tid >> 6), lane = tid & 63, r = lane & 31, hh = lane >> 5;
    constexpr int KST = 400, VST = 136, KBUF = 64 * KST, VBUF = 128 * VST, VOFF = 2 * KBUF;
    static_assert(VOFF + 2 * VBUF <= LDS_BYTES, "lds");
    const int nit = (int)blockIdx.x < 512 ? ((511 - (int)blockIdx.x) / (int)gridDim.x + 1) * 2 : 0;
#define ATT_DECODE(it_, B_, H_, QB_) do { const int pi_ = (int)blockIdx.x + ((it_) >> 1) * (int)gridDim.x, pl_ = pi_ & 255, bh_ = (pi_ >> 8) * 64 + (pl_ & 7) * 8 + ((pl_ >> 3) >> 2), jp_ = (pl_ >> 3) & 3; \
        QB_ = ((it_) & 1) ? jp_ : 7 - jp_; B_ = bh_ >> 4; H_ = bh_ & 15; } while (0)
    bf16x8 qf[12];
    u32x4 kreg[3], vreg[2];
    const bf16_t* knsrc; const bf16_t* krsrc; const bf16_t* vtsrc;
    int tv = tid, rr = r, h2 = hh;
    asm volatile("" : "+v"(tv), "+v"(rr), "+v"(h2));
#define ATT_SETPTR(B_, H_) do { const int skey_ = tv >> 3, sc8_ = tv & 7, sdv_ = tv >> 2, sc4_ = tv & 3; \
        knsrc = KN + (((size_t)(B_) * SEQ + skey_) * 16 + (H_)) * 128 + sc8_ * 8; krsrc = KR + ((size_t)(B_) * SEQ + skey_) * 64 + sc8_ * 8; \
        vtsrc = MVT + (size_t)((H_) * 128 + sdv_) * TH + (size_t)(B_) * SEQ + sc4_ * 8; } while (0)
#define ATT_QLOAD(B_, H_, QB_) do { const size_t tq_ = (size_t)(B_) * SEQ + (QB_) * 256 + 32 * wid + rr; \
        _Pragma("unroll") for (int kk = 0; kk < 12; ++kk) qf[kk] = *(const bf16x8*)(MQ + (tq_ * 16 + (H_)) * 192 + 16 * kk + 8 * h2); } while (0)
#define ATT_LOAD(kt) do { \
    kreg[0] = *(const u32x4*)(knsrc + (size_t)(kt) * 64 * 2048); kreg[1] = *(const u32x4*)(knsrc + (size_t)(kt) * 64 * 2048 + 64); \
    kreg[2] = *(const u32x4*)(krsrc + (size_t)(kt) * 64 * 64); \
    vreg[0] = *(const u32x4*)(vtsrc + (kt) * 64); vreg[1] = *(const u32x4*)(vtsrc + (kt) * 64 + 32); } while (0)
    int b = 0, h = 0, qb = 0;
    if (nit > 0) { ATT_DECODE(0, b, h, qb); ATT_SETPTR(b, h); ATT_QLOAD(b, h, qb); ATT_LOAD(0); }
    for (int it = 0; it < nit; ++it) {
        {
            const int nkt = 4 * (qb + 1);
            const int q0w = qb * 256 + 32 * wid;
            tv = tid; rr = r; h2 = hh;
            asm volatile("" : "+v"(tv), "+v"(rr), "+v"(h2));
            const size_t tokq = (size_t)b * SEQ + q0w + rr;
            const int skey = tv >> 3, sc8 = tv & 7, sdv = tv >> 2, sc4 = tv & 3;
            LAS unsigned char* kdst0 = lds + skey * KST;
            LAS unsigned char* vdst0 = lds + VOFF + sdv * VST + sc4 * 16;
#define ATT_STORE(buf) do { LAS unsigned char* kdst = kdst0 + (buf) * KBUF; LAS unsigned char* vdst = vdst0 + (buf) * VBUF; \
    *(LAS u32x4*)(kdst + sc8 * 16) = kreg[0]; *(LAS u32x4*)(kdst + 128 + sc8 * 16) = kreg[1]; *(LAS u32x4*)(kdst + 256 + sc8 * 16) = kreg[2]; \
    *(LAS u32x2*)(vdst) = (u32x2){vreg[0].x, vreg[0].y}; *(LAS u32x2*)(vdst + 8) = (u32x2){vreg[0].z, vreg[0].w}; \
    *(LAS u32x2*)(vdst + 64) = (u32x2){vreg[1].x, vreg[1].y}; *(LAS u32x2*)(vdst + 72) = (u32x2){vreg[1].z, vreg[1].w}; } while (0)
            __syncthreads();
            ATT_STORE(0);
            if (nkt > 1) ATT_LOAD(1);
            __syncthreads();
            f32x16 o[4];
#pragma unroll
            for (int d = 0; d < 4; ++d)
#pragma unroll
                for (int e = 0; e < 16; ++e) o[d][e] = 0.f;
            float mrun = -1e30f, lrun = 0.f;
            for (int kt = 0; kt < nkt; ++kt) {
                const int buf = kt & 1;
                if (64 * kt <= q0w + 31) {
                    f32x16 s[2];
#pragma unroll
                    for (int jt = 0; jt < 2; ++jt)
#pragma unroll
                        for (int e = 0; e < 16; ++e) s[jt][e] = 0.f;
                    {
                        bf16x8 kf[2][4];
                        const LAS unsigned char* kb = lds + buf * KBUF + r * KST + hh * 16;
#define ATT_KREAD(dst, g_) do { _Pragma("unroll") for (int u = 0; u < 4; ++u) dst[u] = *(const LAS bf16x8*)(kb + (32 * (u & 1)) * KST + (2 * (g_) + (u >> 1)) * 32); } while (0)
                        ATT_KREAD(kf[0], 0);
#pragma unroll
                        for (int gq = 0; gq < 6; ++gq) {
                            if (gq < 5) ATT_KREAD(kf[(gq + 1) & 1], gq + 1);
                            __builtin_amdgcn_sched_barrier(0);
                            __builtin_amdgcn_s_setprio(1);
#pragma unroll
                            for (int u = 0; u < 4; ++u) s[u & 1] = MFMA32(kf[gq & 1][u], qf[2 * gq + (u >> 1)], s[u & 1]);
                            __builtin_amdgcn_s_setprio(0);
                            __builtin_amdgcn_sched_barrier(0);
                        }
#undef ATT_KREAD
                    }
                    const bool diag = 64 * kt + 63 > q0w;
                    float mx = -1e30f;
#pragma unroll
                    for (int jt = 0; jt < 2; ++jt)
#pragma unroll
                        for (int e = 0; e < 16; ++e) {
                            if (diag) { const int key = 64 * kt + 32 * jt + (e & 3) + 8 * (e >> 2) + 4 * hh; if (key > q0w + r) s[jt][e] = -1e30f; }
                            mx = fmaxf(mx, s[jt][e]);
                        }
                    mx = fmaxf(mx, __shfl_xor(mx, 32));
                    if (__builtin_amdgcn_ballot_w64(mx > mrun + 8.0f) != 0ull) {
                        const float mnew = fmaxf(mrun, mx), alpha = fexp2(mrun - mnew);
                        mrun = mnew; lrun *= alpha;
#pragma unroll
                        for (int d = 0; d < 4; ++d)
#pragma unroll
                            for (int e = 0; e < 16; ++e) o[d][e] *= alpha;
                    }
                    float ls = 0.f;
#pragma unroll
                    for (int jt = 0; jt < 2; ++jt)
#pragma unroll
                        for (int e = 0; e < 16; ++e) { const float p = fexp2(s[jt][e] - mrun); s[jt][e] = p; ls += p; }
                    lrun += ls;
                    bf16x8 pf[2][2];
#pragma unroll
                    for (int jt = 0; jt < 2; ++jt) { pf[jt][0] = pack_step(s[jt], 0); pf[jt][1] = pack_step(s[jt], 1); }
                    {
                        bf16x8 vf[2][2];
                        const LAS unsigned char* vbp = lds + VOFF + buf * VBUF + r * VST + hh * 8;
#define ATT_VREAD(dst, g_) do { _Pragma("unroll") for (int u = 0; u < 2; ++u) { const LAS unsigned char* vp = vbp + (32 * ((g_) >> 1)) * VST + (2 * ((g_) & 1) + u) * 32; \
        const s16x4 lo = *(const LAS s16x4*)vp, hi = *(const LAS s16x4*)(vp + 16); dst[u] = __builtin_shufflevector(lo, hi, 0, 1, 2, 3, 4, 5, 6, 7); } } while (0)
                        ATT_VREAD(vf[0], 0);
#pragma unroll
                        for (int g8 = 0; g8 < 8; ++g8) {
                            if (g8 < 7) ATT_VREAD(vf[(g8 + 1) & 1], g8 + 1);
                            __builtin_amdgcn_sched_barrier(0);
                            __builtin_amdgcn_s_setprio(1);
#pragma unroll
                            for (int u = 0; u < 2; ++u) o[g8 >> 1] = MFMA32(vf[g8 & 1][u], pf[g8 & 1][u], o[g8 >> 1]);
                            __builtin_amdgcn_s_setprio(0);
                            __builtin_amdgcn_sched_barrier(0);
                        }
#undef ATT_VREAD
                    }
                }
                if (kt + 1 < nkt) ATT_STORE(buf ^ 1);
                if (kt + 2 < nkt) ATT_LOAD(kt + 2);
                __syncthreads();
            }
            int nb = b, nh = h, nqb = qb;
            if (it + 1 < nit) { ATT_DECODE(it + 1, nb, nh, nqb); ATT_SETPTR(nb, nh); ATT_QLOAD(nb, nh, nqb); ATT_LOAD(0); }
            lrun += __shfl_xor(lrun, 32);
            const float inv = 1.0f / lrun;
            u32x2 gt[4][4];
#pragma unroll
            for (int d = 0; d < 4; ++d)
#pragma unroll
                for (int g4 = 0; g4 < 4; ++g4) gt[d][g4] = *(const u32x2*)(G + tokq * 2048 + h * 128 + 32 * d + 8 * g4 + 4 * h2);
#pragma unroll
            for (int d = 0; d < 4; ++d)
#pragma unroll
                for (int g4 = 0; g4 < 4; ++g4) {
                    bf16_t* gp = G + tokq * 2048 + h * 128 + 32 * d + 8 * g4 + 4 * h2;
                    u32x2 w;
                    w.x = pk2(o[d][4 * g4 + 0] * inv * silu(bflo(gt[d][g4].x)), o[d][4 * g4 + 1] * inv * silu(bfhi(gt[d][g4].x)));
                    w.y = pk2(o[d][4 * g4 + 2] * inv * silu(bflo(gt[d][g4].y)), o[d][4 * g4 + 3] * inv * silu(bfhi(gt[d][g4].y)));
                    *(u32x2*)(gp + gdelta) = w;
                }
            b = nb; h = nh; qb = nqb;
        }
    }
#undef ATT_LOAD
#undef ATT_STORE
#undef ATT_DECODE
#undef ATT_SETPTR
#undef ATT_QLOAD
}

DI void scan_phase(LAS unsigned char* lds, const Params& P, int tid0, bool dry) {
    const size_t gdelta = dry ? (O_DUMMY - O_G) / 2 : 0;
    const int skip = dry ? SCAN_SKIP : 0;
    const bf16_t* RQ = (const bf16_t*)(P.ws + O_RQ); const bf16_t* RK = (const bf16_t*)(P.ws + O_RK);
    const bf16_t* VT = (const bf16_t*)(P.ws + O_RVT);
    bf16_t* G = (bf16_t*)(P.ws + O_G); float* SSQO = (float*)(P.ws + O_SSQO);
    const int tid = tid0, wid = __builtin_amdgcn_readfirstlane(tid >> 6), lane = tid & 63, r = lane & 31, hh = lane >> 5;
    constexpr int KS = 528, TS = 272, SLOT = 64 * KS, VTO = 2 * SLOT, VTB = 64 * TS, VDO = VTO + VTB, RST = 528, RIO = VDO + VTB, RIB = 64 * RST;
    static_assert(RIO + RIB <= LDS_BYTES, "lds");
    const int ib = wid < 4 ? wid : 7 - wid, vh = wid >> 2;
    const int dbw = wid & 3, vb = wid >> 2;
    const int trq = (lane & 15) >> 2, trp = lane & 3, trb = (lane >> 4) & 1;
    for (int it = blockIdx.x; it < 256; it += gridDim.x) {
        const int bhx = (it & 7) * 4 + ((it >> 3) >> 3), sl = (it >> 3) & 7, b = bhx >> 2, h = bhx & 3;
        const int v0 = h * 512 + sl * 64;
        const float lg2 = __builtin_log2f(1.0f - fexp2(-5.0f - (float)h));
        const float cdec = fexp2(128.0f * lg2);
        __syncthreads();
        { unsigned zu = 0u; asm volatile("" : "+v"(zu));
          for (int i = tid; i < RIB / 16; i += 512) *(LAS u32x4*)(lds + RIO + i * 16) = (u32x4){zu, zu, zu, zu}; }
        u32x4 stg[4], vstg[2];
#define SC_LOADK(n_, jh_) do { _Pragma("unroll") for (int i = 0; i < 4; ++i) { const int p = tv + 512 * i; \
        stg[i] = *(const u32x4*)(RK + ((size_t)b * SEQ + (n_) * 128 + (jh_) * 64 + (p >> 5)) * 1024 + h * 256 + (p & 31) * 8); } } while (0)
#define SC_STOREK(slot) do { _Pragma("unroll") for (int i = 0; i < 4; ++i) { const int p = tv + 512 * i; \
        *(LAS u32x4*)(lds + (slot) * SLOT + (p >> 5) * KS + (p & 31) * 16) = stg[i]; } } while (0)
#define SC_VLOAD(n_) do { _Pragma("unroll") for (int i = 0; i < 2; ++i) { const int p = tv + 512 * i, row = p >> 4, ch = p & 15; \
        vstg[i] = *(const u32x4*)(VT + (size_t)(v0 + row) * TH + (size_t)b * SEQ + (n_) * 128 + ch * 8); } } while (0)
#define SC_VSTORE() do { _Pragma("unroll") for (int i = 0; i < 2; ++i) { const int p = tv + 512 * i, row = p >> 4, ch = p & 15; \
        *(LAS u32x4*)(lds + VTO + row * TS + ch * 16) = vstg[i]; \
        u32x4 dv_; const float e0_ = (float)(127 - 8 * ch); \
        dv_.x = pk2(bflo(vstg[i].x) * fexp2((e0_ - 0.f) * lg2), bfhi(vstg[i].x) * fexp2((e0_ - 1.f) * lg2)); \
        dv_.y = pk2(bflo(vstg[i].y) * fexp2((e0_ - 2.f) * lg2), bfhi(vstg[i].y) * fexp2((e0_ - 3.f) * lg2)); \
        dv_.z = pk2(bflo(vstg[i].z) * fexp2((e0_ - 4.f) * lg2), bfhi(vstg[i].z) * fexp2((e0_ - 5.f) * lg2)); \
        dv_.w = pk2(bflo(vstg[i].w) * fexp2((e0_ - 6.f) * lg2), bfhi(vstg[i].w) * fexp2((e0_ - 7.f) * lg2)); \
        *(LAS u32x4*)(lds + VDO + row * TS + ch * 16) = dv_; } } while (0)
        int tv = tid, rr = r, h2 = hh;
        asm volatile("" : "+v"(tv), "+v"(rr), "+v"(h2));
        SC_LOADK(0, 0); SC_STOREK(0); SC_VLOAD(0); SC_VSTORE();
        __syncthreads();
        f32x16 X0, X1, oi;
        bf16x8 qa[8], qb[8];
#define SC_QLOAD(dst, n_, kh_) do { _Pragma("unroll") for (int kk = 0; kk < 8; ++kk) \
        dst[kk] = *(const bf16x8*)(RQ + (((((size_t)b * SEQ + (n_) * 128 + 32 * ib) >> 5) * 4 + h) * 16 + 8 * (kh_) + kk) * 512 + (h2 * 32 + rr) * 8); } while (0)
        SC_QLOAD(qa, 0, 0);
#pragma unroll
        for (int e = 0; e < 16; ++e) { X0[e] = 0.f; X1[e] = 0.f; oi[e] = 0.f; }
        for (int gs = 0; gs < 32; ++gs) {
            const int n = gs >> 1, s = gs & 1;
            const size_t tokb = (size_t)b * SEQ + n * 128;
            int iq = 32 * ib + r;
            tv = tid; rr = r; h2 = hh;
            asm volatile("" : "+v"(iq), "+v"(tv), "+v"(rr), "+v"(h2));
            if (s == 0) SC_LOADK(n, 1);
            else if (n < 15) { SC_LOADK(n + 1, 0); SC_VLOAD(n + 1); }
            if (!(skip & 16)) SC_QLOAD(qb, n, 1);
            {
                const bool act = 2 * s <= ib, two = 2 * s + 1 <= ib;
                f32x16 st[2];
#pragma unroll
                for (int jj = 0; jj < 2; ++jj)
#pragma unroll
                    for (int e = 0; e < 16; ++e) st[jj][e] = 0.f;
                if (s == 0) {
#pragma unroll
                    for (int e = 0; e < 16; ++e) oi[e] = 0.f;
                }
                {
                    bf16x8 fk0[1][2], fk1[1][2], fr[1][2];
                    const LAS unsigned char* kb0 = lds + s * SLOT + r * KS + hh * 16;
                    const LAS unsigned char* rb0 = lds + RIO + (32 * vh + r) * RST + hh * 16;
#define SC_FREAD(bi, g_) do { _Pragma("unroll") for (int u = 0; u < 2; ++u) { \
        fk0[bi][u] = *(const LAS bf16x8*)(kb0 + (2 * (g_) + u) * 32); fk1[bi][u] = *(const LAS bf16x8*)(kb0 + 32 * KS + (2 * (g_) + u) * 32); \
        fr[bi][u] = *(const LAS bf16x8*)(rb0 + (2 * (g_) + u) * 32); } } while (0)
#pragma unroll
                    for (int g8 = 0; g8 < 8; ++g8) {
                        SC_FREAD(0, g8);
                        __builtin_amdgcn_sched_barrier(0);
#pragma unroll
                        for (int u = 0; u < 2; ++u) {
                            const int ks = 2 * g8 + u;
                            const bf16x8 q = ks < 8 ? qa[ks & 7] : qb[ks & 7];
                            if (act && !(skip & 1)) st[0] = MFMA32(fk0[0][u], q, st[0]);
                            if (two && !(skip & 1)) st[1] = MFMA32(fk1[0][u], q, st[1]);
                            if (s == 0 && !(skip & 2)) oi = MFMA32(fr[0][u], q, oi);
                        }
                        __builtin_amdgcn_sched_barrier(0);
                    }
#undef SC_FREAD
                }
                if (s == 0) {
                    const float qd = fexp2((float)(iq + 1) * lg2);
#pragma unroll
                    for (int e = 0; e < 16; ++e) oi[e] *= qd;
                }
                if (act) {
#pragma unroll
                    for (int jj = 0; jj < 2; ++jj)
                        if (jj == 0 || two) {
                            const int jt = 2 * s + jj;
#pragma unroll
                            for (int e = 0; e < 16; ++e) { const int j = 32 * jt + (e & 3) + 8 * (e >> 2) + 4 * h2;
                                st[jj][e] = j <= iq ? st[jj][e] * fexp2((float)(iq - j) * lg2) : 0.f; }
#pragma unroll
                            for (int si = 0; si < 2; ++si) {
                                const bf16x8 pf = pack_step(st[jj], si);
                                const LAS unsigned char* vp = lds + VTO + (32 * vh + r) * TS + (32 * jt + 16 * si + 4 * hh) * 2;
                                const s16x4 lo = *(const LAS s16x4*)vp, hi = *(const LAS s16x4*)(vp + 16);
                                const bf16x8 vf = __builtin_shufflevector(lo, hi, 0, 1, 2, 3, 4, 5, 6, 7);
                                oi = MFMA32(vf, pf, oi);
                            }
                        }
                }
            }
            if (s == 0) {
                SC_STOREK(1);
                __syncthreads();
            } else {
                if (!(skip & 8)) {
                    float ss = 0.f;
#pragma unroll
                    for (int e = 0; e < 16; ++e) ss += oi[e] * oi[e];
                    ss += __shfl_xor(ss, 32);
                    const size_t tok = tokb + iq;
                    if (h2 == 0) SSQO[(tok * 4 + h) * 16 + sl * 2 + vh] = ss;
                    u32x2 gts[4];
#pragma unroll
                    for (int g4 = 0; g4 < 4; ++g4) gts[g4] = *(const u32x2*)(G + tok * 2048 + v0 + 32 * vh + 8 * g4 + 4 * h2);
#pragma unroll
                    for (int g4 = 0; g4 < 4; ++g4) {
                        bf16_t* gp = G + tok * 2048 + v0 + 32 * vh + 8 * g4 + 4 * h2;
                        const u32x2 gt = gts[g4];
                        u32x2 w;
                        w.x = pk2(oi[4 * g4 + 0] * silu(bflo(gt.x)), oi[4 * g4 + 1] * silu(bfhi(gt.x)));
                        w.y = pk2(oi[4 * g4 + 2] * silu(bflo(gt.y)), oi[4 * g4 + 3] * silu(bfhi(gt.y)));
                        *(u32x2*)(gp + gdelta) = w;
                    }
                }
                if (n < 15 && !(skip & 4)) {
                    SC_QLOAD(qa, n + 1, 0);
#pragma unroll
                    for (int e = 0; e < 16; ++e) { X0[e] *= cdec; X1[e] *= cdec; }
#pragma unroll
                    for (int kk = 0; kk < 8; ++kk) {
                        const LAS unsigned char* kp = lds + (kk >> 2) * SLOT + (16 * (kk & 3) + 8 * hh + trq) * KS + (32 * dbw + 16 * trb + 4 * trp) * 2;
                        const s16x4 t0 = __builtin_amdgcn_ds_read_tr16_b64_v4i16((LAS s16x4*)kp);
                        const s16x4 t1 = __builtin_amdgcn_ds_read_tr16_b64_v4i16((LAS s16x4*)(kp + 4 * KS));
                        const s16x4 t2 = __builtin_amdgcn_ds_read_tr16_b64_v4i16((LAS s16x4*)(kp + 256));
                        const s16x4 t3 = __builtin_amdgcn_ds_read_tr16_b64_v4i16((LAS s16x4*)(kp + 256 + 4 * KS));
                        const bf16x8 af0 = __builtin_shufflevector(t0, t1, 0, 1, 2, 3, 4, 5, 6, 7), af1 = __builtin_shufflevector(t2, t3, 0, 1, 2, 3, 4, 5, 6, 7);
                        const bf16x8 bf = *(const LAS bf16x8*)(lds + VDO + (32 * vb + r) * TS + (16 * kk + 8 * hh) * 2);
                        X0 = MFMA32(af0, bf, X0);
                        X1 = MFMA32(af1, bf, X1);
                    }
#pragma unroll
                    for (int g4 = 0; g4 < 4; ++g4) {
                        u32x2 w0, w1; w0.x = pk2(X0[4 * g4 + 0], X0[4 * g4 + 1]); w0.y = pk2(X0[4 * g4 + 2], X0[4 * g4 + 3]);
                        w1.x = pk2(X1[4 * g4 + 0], X1[4 * g4 + 1]); w1.y = pk2(X1[4 * g4 + 2], X1[4 * g4 + 3]);
                        *(LAS u32x2*)(lds + RIO + (32 * vb + r) * RST + (32 * dbw + 8 * g4 + 4 * hh) * 2) = w0;
                        *(LAS u32x2*)(lds + RIO + (32 * vb + r) * RST + (128 + 32 * dbw + 8 * g4 + 4 * hh) * 2) = w1;
                    }
                }
                __syncthreads();
                if (n < 15) { SC_STOREK(0); SC_VSTORE(); }
                __syncthreads();
            }
        }
#undef SC_LOADK
#undef SC_STOREK
#undef SC_VLOAD
#undef SC_VSTORE
#undef SC_QLOAD
    }
}

#define XB_TMO      128
#define XB_XCNT(j)  (256  + 64 * (j))
#define XB_XSUB(j)  (1280 + 64 * (j))
#define XB_XGEN(j)  (2304 + 64 * (j))
#define XB_TOP      3328
#define XB_TOPGEN   3392
#define XCD_BAR_WORDS 3456
#define XB_SPIN_CAP (1u << 18)
DI unsigned xb_ld(unsigned* p)              { return __hip_atomic_load(p, __ATOMIC_RELAXED, __HIP_MEMORY_SCOPE_AGENT); }
DI unsigned xb_add(unsigned* p, unsigned v) { return __hip_atomic_fetch_add(p, v, __ATOMIC_RELAXED, __HIP_MEMORY_SCOPE_AGENT); }
DI unsigned xb_xcc_id() { return (unsigned)__builtin_amdgcn_s_getreg((3 << 11) | 20) & 0xFu; }
#define XB_SPIN(cond, bar) do { while (cond) __builtin_amdgcn_s_sleep(1); } while (0)
DI void xcd_barrier_complete(unsigned* bar, unsigned x, unsigned& nloc, unsigned& nx) {
    const unsigned G = gridDim.x;
    unsigned sum, cnt, mine;
    for (;;) {
        sum = 0u; cnt = 0u; mine = 0u;
#pragma unroll
        for (unsigned j = 0; j < 16; ++j) { const unsigned c = xb_ld(&bar[XB_XCNT(j)]); sum += c; cnt += (c > 0u) ? 1u : 0u; mine = (j == x) ? c : mine; }
        if (sum == G) break;
        __builtin_amdgcn_s_sleep(1);
    }
    nloc = mine > 0u ? mine : 1u; nx = cnt > 0u ? cnt : 1u;
}
DI void xcd_barrier(unsigned* bar, unsigned x, volatile LAS unsigned* st, bool leader_thread) {
    asm volatile("s_waitcnt vmcnt(0)" ::: "memory");
    __syncthreads();
    if (leader_thread) {
        __builtin_amdgcn_s_waitcnt(0);
        unsigned nloc = st[0], nx = st[1];
        if (nloc == 0u) { xcd_barrier_complete(bar, x, nloc, nx); st[0] = nloc; st[1] = nx; }
        const unsigned old = xb_add(&bar[XB_XSUB(x)], 1u);
        const unsigned gen = old / nloc;
        if (old + 1u == (gen + 1u) * nloc) {
            __builtin_amdgcn_fence(__ATOMIC_RELEASE, "agent");
            asm volatile("s_waitcnt vmcnt(0)" ::: "memory");
            const unsigned og = xb_add(&bar[XB_TOP], 1u);
            const unsigned tg = og / nx;
            if (og + 1u == (tg + 1u) * nx) xb_add(&bar[XB_TOPGEN], 1u);
            else XB_SPIN(xb_ld(&bar[XB_TOPGEN]) == tg, bar);
            __builtin_amdgcn_fence(__ATOMIC_ACQUIRE, "agent");
            xb_add(&bar[XB_XGEN(x)], 1u);
            asm volatile("s_waitcnt vmcnt(0)" ::: "memory");
        } else {
            XB_SPIN(xb_ld(&bar[XB_XGEN(x)]) == gen, bar);
            __builtin_amdgcn_fence(__ATOMIC_ACQUIRE, "agent");
            asm volatile("s_waitcnt vmcnt(0)" ::: "memory");
        }
    }
    __syncthreads();
}

constexpr int NPHASES = 37;

DI int phase_kind(int ph) {
    if (ph == 0) return 0;
    const int q = (ph - 1) % 18; if (q == 0) return 3; if (q == 17) return 0;
    const int l = (q - 1) >> 2, s = (q - 1) & 3;
    if ((l & 1) == 0) return s == 0 ? 1 : s == 1 ? 2 : s == 2 ? 3 : 4;
    return s == 0 ? 5 : s == 1 ? 6 : s == 2 ? 7 : 4;
}
DI void run_phase(LAS unsigned char* lds, const Params& P, int ph, int wave_s, bool dry) {
    int tid0;
    asm volatile("v_mbcnt_lo_u32_b32 %0, -1, 0\n\tv_mbcnt_hi_u32_b32 %0, -1, %0" : "=v"(tid0));
    tid0 += wave_s * 64;
    if (ph == 0) { wprep_phase(lds, P, tid0); xprep_phase(P, 0, tid0); return; }
    const int half = (ph - 1) / 18, q = (ph - 1) % 18;
    if (q == 0) return;
    if (q == 17) { final_phase(P, half, tid0, dry); if (half == 0 && !dry) xprep_phase(P, 1, tid0); return; }
    const int l = (q - 1) >> 2, s = (q - 1) & 3;
    unsigned char* ws = P.ws;
    const int* pos = P.pos + (size_t)half * TH;
    if ((l & 1) == 0) {
        const int li = l >> 1;
        unsigned char* wb = ws + W_RET + (size_t)li * 16 * MiB;
        if (s == 1) { if (EN_SCAN) scan_phase(lds, P, tid0, dry); return; }
        if (s == 2) { gnorm_phase(P, tid0, dry); return; }
        const int ng = s == 0 ? 2 : 1;
        for (int gi = 0; gi < ng; ++gi) {
            GemmD g{};
            g.pos = pos; g.ssq_in = (const float*)(ws + ((half == 1 && l == 0) ? O_SSQH2 : O_SSQH));
            if (s == 0 && gi == 0) {
                g.A = (const bf16_t*)(ws + O_HB); g.Bt = (const bf16_t*)wb; g.lda = 1024; g.ldb = 1024; g.K = 1024; g.nM = 64; g.nN = 16; g.bskip_from = 8; g.bskip_add = 8; g.epi = E_RETQG;
                g.o0 = (bf16_t*)(ws + O_RQ); g.o1 = (bf16_t*)(ws + O_RK); g.o2 = (bf16_t*)(ws + O_G);
            } else if (s == 0) {
                g.A = (const bf16_t*)wb + (size_t)2048 * 1024; g.Bt = (const bf16_t*)(ws + O_HB); g.lda = 1024; g.ldb = 1024; g.K = 1024; g.nM = 8; g.nN = 64; g.bskip_from = 1 << 30; g.epi = E_VB;
                g.o1 = (bf16_t*)(ws + O_RVT); g.lg2a = 1.0f;
            } else {
                g.A = (const bf16_t*)(ws + O_G); g.Bt = (const bf16_t*)(wb + 12 * MiB); g.lda = 2048; g.ldb = 2048; g.K = 2048; g.nM = 64; g.nN = 4; g.bskip_from = 1 << 30; g.epi = E_OUT;
                g.kscale = (const float*)(ws + O_SSQO);
                g.hin = (l == 0 ? P.x : P.out) + (size_t)half * TH * DM; g.hout = P.out + (size_t)half * TH * DM;
                g.o0 = (bf16_t*)(ws + O_HB); g.ssq_out = (float*)(ws + O_SSQH);
                if (dry) { g.hout = (float*)(ws + O_DUMMY); g.o0 = (bf16_t*)(ws + O_DUMMY + 64 * MiB); g.ssq_out = (float*)(ws + O_DUMMY + 96 * MiB); }
            }
            if (EN_GEMM) gemm_phase(lds, g, tid0);
        }
    } else {
        const int li = l >> 1;
        unsigned char* wb = ws + W_MLA + (size_t)li * W_MLA_SZ;
        if (s == 2) { if (EN_ATTN) attn_phase(lds, P, tid0, dry); return; }
        const int ng = s == 1 ? 3 : 1;
        for (int gi = 0; gi < ng; ++gi) {
            GemmD g{};
            g.pos = pos; g.bskip_from = 1 << 30;
            if (s == 0) {
                g.A = (const bf16_t*)(ws + O_HB); g.Bt = (const bf16_t*)wb; g.lda = 1024; g.ldb = 1024; g.K = 1024; g.nM = 64; g.nN = 10; g.epi = E_MLAIN;
                g.ssq_in = (const float*)(ws + O_SSQH); g.o0 = (bf16_t*)(ws + O_LAT); g.o1 = (bf16_t*)(ws + O_KROPE); g.o2 = (bf16_t*)(ws + O_G);
                g.ssq_out = (float*)(ws + O_SSQQ); g.ssq_out2 = (float*)(ws + O_SSQKV);
            } else if (s == 1 && gi == 0) {
                g.A = (const bf16_t*)(ws + O_LAT); g.Bt = (const bf16_t*)(wb + 5 * MiB); g.lda = 384; g.ldb = 256; g.K = 256; g.nM = 64; g.nN = 12; g.epi = E_QB;
                g.ssq_in = (const float*)(ws + O_SSQQ); g.o0 = (bf16_t*)(ws + O_MQ);
            } else if (s == 1 && gi == 1) {
                g.A = (const bf16_t*)(ws + O_LAT) + 256; g.Bt = (const bf16_t*)(wb + 6 * MiB + MiB / 2); g.lda = 384; g.ldb = 128; g.K = 128; g.nM = 64; g.nN = 8; g.epi = E_KB;
                g.ssq_in = (const float*)(ws + O_SSQKV); g.o0 = (bf16_t*)(ws + O_KN);
            } else if (s == 1) {
                g.A = (const bf16_t*)(wb + 7 * MiB + MiB / 2); g.Bt = (const bf16_t*)(ws + O_LAT) + 256; g.lda = 128; g.ldb = 384; g.K = 128; g.nM = 8; g.nN = 64; g.epi = E_VB;
                g.ssq_in = (const float*)(ws + O_SSQKV); g.o1 = (bf16_t*)(ws + O_MVT);
            } else {
                g.A = (const bf16_t*)(ws + O_G); g.Bt = (const bf16_t*)(wb + 8 * MiB + MiB / 2); g.lda = 2048; g.ldb = 2048; g.K = 2048; g.nM = 64; g.nN = 4; g.epi = E_OUT;
                g.hin = P.out + (size_t)half * TH * DM; g.hout = P.out + (size_t)half * TH * DM;
                g.o0 = l == 3 ? nullptr : (bf16_t*)(ws + O_HB); g.ssq_out = (float*)(ws + O_SSQH);
                if (dry) { g.hout = (float*)(ws + O_DUMMY); g.o0 = (bf16_t*)(ws + O_DUMMY + 64 * MiB); g.ssq_out = (float*)(ws + O_DUMMY + 96 * MiB); }
            }
            if (EN_GEMM) gemm_phase(lds, g, tid0);
        }
    }
}

__global__ void __launch_bounds__(512, 2) trunk_megakernel(Params P) {
    extern __shared__ __attribute__((aligned(16))) unsigned char shm[];
    LAS unsigned char* lds = (LAS unsigned char*)shm;
    cg::grid_group grid = cg::this_grid();
    const int wave_s = __builtin_amdgcn_readfirstlane((int)(threadIdx.x >> 6));
    volatile LAS unsigned* st = (volatile LAS unsigned*)(lds + LDS_BYTES);
    unsigned* bar = (unsigned*)(P.ws + O_BAR);
    const unsigned xcc = xb_xcc_id();
    const bool use_xb = P.ph_hi - P.ph_lo > 1;
    if (use_xb) {
        if (threadIdx.x == 0) { st[0] = 0u; st[1] = 0u; (void)xb_add(&bar[XB_XCNT(xcc)], 1u); }
        __syncthreads();
    }
    const int ph_hi = __builtin_amdgcn_readfirstlane(P.ph_hi), ph_lo = __builtin_amdgcn_readfirstlane(P.ph_lo);
    int ph = ph_lo;
    if (ph < ph_hi) for (;;) {
        int nrep = (PROBE_DUP && ((PROBE_DUP >> phase_kind(ph)) & 2)) ? 2 : 1;
        if (phase_kind(ph) == 3) nrep = 0;
        if (nrep > 0) for (;;) {
            --nrep;
            run_phase(lds, P, ph, wave_s, nrep > 0);
            if (nrep > 0 || ph + 1 < ph_hi) {
                if (ph_lo < 0) grid.sync();
                else {
                    int l0; asm volatile("v_mbcnt_lo_u32_b32 %0, -1, 0\n\tv_mbcnt_hi_u32_b32 %0, -1, %0" : "=v"(l0));
                    for (int k = 0; k < 1 + (PROBE_DUP & 1); ++k) xcd_barrier(bar, xcc, st, wave_s == 0 && l0 == 0);
                }
            }
            nrep = __builtin_amdgcn_readfirstlane(nrep);
            if (nrep <= 0) break;
        }
        ph = __builtin_amdgcn_readfirstlane(ph + 1);
        if (ph >= ph_hi) break;
    }
}

extern "C" void kernel_launch(void* const* d_in, const int* in_sizes, int n_in, void* d_out, int out_size, void* d_ws, size_t ws_size, hipStream_t stream) {
    static int grid_blocks = 0;
    if (grid_blocks == 0) {
        if (n_in != 25 || ws_size < WS_NEED) { fprintf(stderr, "kernel_launch: unexpected n_in %d / ws %zu\n", n_in, ws_size); grid_blocks = -1; return; }
        int dev = 0, cus = 0, per_cu = 0;
        hipGetDevice(&dev);
        hipDeviceGetAttribute(&cus, hipDeviceAttributeMultiprocessorCount, dev);
        if (hipFuncSetAttribute((const void*)trunk_megakernel, hipFuncAttributeMaxDynamicSharedMemorySize, LDS_BYTES + 16) != hipSuccess) { fprintf(stderr, "hipFuncSetAttribute failed\n"); grid_blocks = -1; return; }
        hipOccupancyMaxActiveBlocksPerMultiprocessor(&per_cu, (const void*)trunk_megakernel, 512, LDS_BYTES + 16);
        if (per_cu < 1) per_cu = 1;
        if (per_cu > 1) per_cu = 1;
        grid_blocks = cus * per_cu;
        (void)hipGetLastError();
    }
    if (grid_blocks < 0) return;
    Params p{};
    p.x = (const float*)d_in[0]; p.pos = (const int*)d_in[1];
    p.lnorm[0] = (const float*)d_in[2]; p.ret_win[0] = (const float*)d_in[3]; p.ret_gn[0] = (const float*)d_in[4]; p.ret_wout[0] = (const float*)d_in[5];
    p.lnorm[1] = (const float*)d_in[6]; p.mla_win[0] = (const float*)d_in[7]; p.mla_qn[0] = (const float*)d_in[8]; p.mla_wqb[0] = (const float*)d_in[9];
    p.mla_kvn[0] = (const float*)d_in[10]; p.mla_wkvb[0] = (const float*)d_in[11]; p.mla_wout[0] = (const float*)d_in[12];
    p.lnorm[2] = (const float*)d_in[13]; p.ret_win[1] = (const float*)d_in[14]; p.ret_gn[1] = (const float*)d_in[15]; p.ret_wout[1] = (const float*)d_in[16];
    p.lnorm[3] = (const float*)d_in[17]; p.mla_win[1] = (const float*)d_in[18]; p.mla_qn[1] = (const float*)d_in[19]; p.mla_wqb[1] = (const float*)d_in[20];
    p.mla_kvn[1] = (const float*)d_in[21]; p.mla_wkvb[1] = (const float*)d_in[22]; p.mla_wout[1] = (const float*)d_in[23];
    p.fnorm = (const float*)d_in[24];
    p.out = (float*)d_out; p.ws = (unsigned char*)d_ws;
#if MULTI_LAUNCH
    for (int ph = 0; ph < NPHASES; ++ph) {
        p.ph_lo = ph; p.ph_hi = ph + 1;
        hipLaunchKernelGGL(trunk_megakernel, dim3(grid_blocks), dim3(512), LDS_BYTES + 16, stream, p);
    }
#else
    p.ph_lo = 0; p.ph_hi = NPHASES;
    if (hipMemsetAsync((char*)d_ws + O_BAR, 0, XCD_BAR_WORDS * 4, stream) != hipSuccess) { fprintf(stderr, "memset failed\n"); return; }
    void* args[] = {&p};
    hipError_t e = hipLaunchCooperativeKernel((const void*)trunk_megakernel, dim3(grid_blocks), dim3(512), args, LDS_BYTES + 16, stream);
    if (e != hipSuccess) fprintf(stderr, "cooperative launch failed: %s (grid %d)\n", hipGetErrorString(e), grid_blocks);
#endif
}
```

```cpp
#include <hip/hip_runtime.h>
#include <hip/hip_cooperative_groups.h>
#include <cstdio>
namespace cg = cooperative_groups;

#ifndef MULTI_LAUNCH
#define MULTI_LAUNCH 0
#endif

#ifndef PROBE_DUP
#define PROBE_DUP 0
#endif
#ifndef SCAN_SKIP
#define SCAN_SKIP 0
#endif
#ifndef EPI_MASK
#define EPI_MASK 127
#endif
#ifndef EN_GEMM
#define EN_GEMM 1
#endif
#ifndef EN_ATTN
#define EN_ATTN 1
#endif
#ifndef EN_SCAN
#define EN_SCAN 1
#endif
#define LAS __attribute__((address_space(3)))
#define DI __device__ __forceinline__
typedef unsigned short bf16_t;
typedef short bf16x8 __attribute__((ext_vector_type(8)));
typedef short s16x4 __attribute__((ext_vector_type(4)));
typedef float f32x4 __attribute__((ext_vector_type(4)));
typedef float f32x16 __attribute__((ext_vector_type(16)));
typedef unsigned u32x4 __attribute__((ext_vector_type(4)));
typedef unsigned u32x2 __attribute__((ext_vector_type(2)));

constexpr int TH = 16384;
constexpr int SEQ = 2048;
constexpr int DM = 1024;
constexpr int LDS_BYTES = 147456;
constexpr float EPS = 1e-6f;
constexpr float LOG2_1E4 = 13.287712379549449f;
constexpr float LOG2E = 1.4426950408889634f;
constexpr size_t MiB = (size_t)1 << 20;

constexpr size_t W_RET = 0;
constexpr size_t W_MLA = 32 * MiB;
constexpr size_t W_MLA_SZ = 12 * MiB + MiB / 2;
constexpr size_t O_HB = 57 * MiB;
constexpr size_t O_SSQH = 89 * MiB;
constexpr size_t O_G = 90 * MiB;
constexpr size_t O_RQ = 154 * MiB;
constexpr size_t O_RK = 186 * MiB;
constexpr size_t O_RKDT = 218 * MiB;
constexpr size_t O_RVT = 250 * MiB;
constexpr size_t O_SSQO = 314 * MiB;
constexpr size_t O_LAT = 154 * MiB;
constexpr size_t O_KROPE = 166 * MiB;
constexpr size_t O_SSQQ = 168 * MiB;
constexpr size_t O_SSQKV = 168 * MiB + MiB / 4;
constexpr size_t O_MQ = 169 * MiB;
constexpr size_t O_KN = 265 * MiB;
constexpr size_t O_MVT = 329 * MiB;
constexpr size_t WS_NEED = 393 * MiB;
constexpr size_t O_SSQH2 = 395 * MiB;
constexpr size_t O_BAR = 396 * MiB;
constexpr size_t O_DUMMY = 400 * MiB;

struct Params {
    const float* x; const int* pos;
    const float* lnorm[4];
    const float* ret_win[2]; const float* ret_gn[2]; const float* ret_wout[2];
    const float* mla_win[2]; const float* mla_qn[2]; const float* mla_wqb[2]; const float* mla_kvn[2]; const float* mla_wkvb[2]; const float* mla_wout[2];
    const float* fnorm;
    float* out; unsigned char* ws;
    int ph_lo, ph_hi;
};

DI unsigned pk2(float lo, float hi) {
    typedef __bf16 bf2 __attribute__((ext_vector_type(2)));
    typedef float f2 __attribute__((ext_vector_type(2)));
    f2 v = {lo, hi};
    bf2 b = __builtin_convertvector(v, bf2);
    return __builtin_bit_cast(unsigned, b);
}
DI float bflo(unsigned u) { return __uint_as_float(u << 16); }
DI float bfhi(unsigned u) { return __uint_as_float(u & 0xffff0000u); }
DI float fexp2(float x) { return __builtin_amdgcn_exp2f(x); }
DI void sincos_rev(float ang, float& s, float& c) {
    float rev = ang * 0.15915494309189535f;
    rev = __builtin_amdgcn_fractf(rev);
    s = __builtin_amdgcn_sinf(rev);
    c = __builtin_amdgcn_cosf(rev);
}
DI float silu(float x) { return x * __builtin_amdgcn_rcpf(1.0f + fexp2(-x * LOG2E)); }
DI float rstd_parts(const float* p, int nparts4, float invn) {
    float s = 0.f;
    for (int i = 0; i < nparts4; ++i) { f32x4 v = *(const f32x4*)(p + 4 * i); s += (v.x + v.y) + (v.z + v.w); }
    return __builtin_amdgcn_rsqf(s * invn + EPS);
}
DI u32x4 pack8(const f32x4& a, const f32x4& b, float sc) {
    u32x4 w; w.x = pk2(a[0] * sc, a[1] * sc); w.y = pk2(a[2] * sc, a[3] * sc); w.z = pk2(b[0] * sc, b[1] * sc); w.w = pk2(b[2] * sc, b[3] * sc); return w;
}
#define MFMA32(a, b, c) __builtin_amdgcn_mfma_f32_32x32x16_bf16((a), (b), (c), 0, 0, 0)
DI bf16x8 pack_step(const f32x16& x, int s) {
    u32x4 p;
    p.x = pk2(x[8 * s + 0], x[8 * s + 1]); p.y = pk2(x[8 * s + 2], x[8 * s + 3]); p.z = pk2(x[8 * s + 4], x[8 * s + 5]); p.w = pk2(x[8 * s + 6], x[8 * s + 7]);
    return __builtin_bit_cast(bf16x8, p);
}

namespace pg8 {
constexpr int BM = 256, BK = 64, HALF = 128, HTB = HALF * BK * 2, NXCD = 8, WGM = 8;
DI int lds_byte(int r, int c) { const int st = (r >> 4) * 2 + (c >> 5), rr = r & 15, cc = c & 31, ob = rr * 64 + cc * 2; return st * 1024 + (ob ^ (((ob >> 9) & 1) << 5)); }
DI void stage_rc(int b, int& R, int& C) { const int st = b / 1024, sb = b % 1024, swz = sb ^ (((sb >> 9) & 1) << 5); R = (st >> 1) * 16 + swz / 64; C = (st & 1) * 32 + (swz % 64) / 2; }
DI int perm32(int rho) { const int n = rho >> 4, i = rho & 15; return 8 * (i >> 2) + 4 * n + (i & 3); }
struct Unit { int pm, pn; };
struct StaticOrder {
    int nM, nN, nwg, G, c;
    DI void init(int nM_, int nN_, int G_, int c_) { nM = nM_; nN = nN_; nwg = nM * nN; G = G_; c = c_; }
    DI bool next(int i, Unit& u) const {
        const long L = (long)i * G + c; if (L >= nwg) return false;
        int wgid = (int)L; { const int q = nwg / NXCD, r = nwg % NXCD, xcd = wgid % NXCD, off = wgid / NXCD; wgid = (xcd < r ? xcd * (q + 1) : r * (q + 1) + (xcd - r) * q) + off; }
        const int nig = WGM * nN, gid = wgid / nig, fm = gid * WGM, gsz = (nM - fm) < WGM ? (nM - fm) : WGM;
        u.pm = fm + ((wgid % nig) % gsz); u.pn = (wgid % nig) / gsz; return true;
    }
};
}

enum { E_RETQG = 0, E_RETT, E_OUT, E_MLAIN, E_QB, E_KB, E_VB };
struct GemmD {
    const bf16_t* A; const bf16_t* Bt; int lda, ldb, K, nM, nN, bskip_from, bskip_add, epi;
    const int* pos;
    const float* ssq_in;
    float* ssq_out; float* ssq_out2;
    bf16_t* o0; bf16_t* o1; bf16_t* o2;
    const float* hin; float* hout;
    float lg2a, lg2b, lg2c, lg2d;
    const float* kscale;
};

typedef f32x4 AccT[2][2][4][2];

DI void rope_pair8(const f32x4& a0, const f32x4& a1, const f32x4& b0, const f32x4& b1, float rs, float posf, int i0, float fexp, float osc, u32x4& lo, u32x4& hi) {
#pragma unroll
    for (int e2 = 0; e2 < 4; ++e2) {
        float o0[2], o1[2];
#pragma unroll
        for (int t = 0; t < 2; ++t) {
            const int e = 2 * e2 + t;
            const float v0 = (e < 4 ? a0[e & 3] : a1[e & 3]) * rs, v1 = (e < 4 ? b0[e & 3] : b1[e & 3]) * rs;
            const float invf = fexp2(-(float)(i0 + e) * fexp);
            float sn, cs; sincos_rev(posf * invf, sn, cs);
            o0[t] = (v0 * cs - v1 * sn) * osc; o1[t] = (v1 * cs + v0 * sn) * osc;
        }
        lo[e2] = pk2(o0[0], o0[1]); hi[e2] = pk2(o1[0], o1[1]);
        if (e2 & 1) __builtin_amdgcn_sched_barrier(0);
    }
}

DI void row_stats(const GemmD& g, int pm, int wr, int fr, int fq, bool p16, float invn, float (&rsr)[2][4], int (&posr)[2][4]) {
    f32x4 pv[2][4];
#pragma unroll
    for (int ai = 0; ai < 2; ++ai)
#pragma unroll
        for (int m = 0; m < 4; ++m) {
            const int row = pm * 256 + ai * 128 + wr * 64 + m * 16 + fr;
            pv[ai][m] = p16 ? *(const f32x4*)(g.ssq_in + (size_t)row * 16 + 4 * fq) : *(const f32x4*)(g.ssq_in + (size_t)row * 4);
            posr[ai][m] = g.pos[row];
        }
#pragma unroll
    for (int ai = 0; ai < 2; ++ai)
#pragma unroll
        for (int m = 0; m < 4; ++m) {
            float sm = (pv[ai][m].x + pv[ai][m].y) + (pv[ai][m].z + pv[ai][m].w);
            if (p16) { sm += __shfl_xor(sm, 16); sm += __shfl_xor(sm, 32); }
            rsr[ai][m] = __builtin_amdgcn_rsqf(sm * invn + EPS);
        }
}

DI void gemm_epilogue(const GemmD& g, const AccT& acc, const pg8::Unit& u, int wr, int wc, int fr_, int fq_) {
    const int pm = u.pm, pn = u.pn;
    int fr = fr_, fq = fq_;
    asm volatile("" : "+v"(fr), "+v"(fq));
    const int cw = 32 * wc + 8 * fq;
    float rsr[2][4]; int posr[2][4];
    if (((EPI_MASK >> E_RETQG) & 1) && g.epi == E_RETQG) {
        row_stats(g, pm, wr, fr, fq, true, 1.0f / 1024.0f, rsr, posr);
#pragma unroll
        for (int ai = 0; ai < 2; ++ai)
#pragma unroll
            for (int m = 0; m < 4; ++m) {
                const int row = pm * 256 + ai * 128 + wr * 64 + m * 16 + fr;
                const float rs = rsr[ai][m];
                if (pn < 8) {
                    const int head = pn & 3; const bool isk = pn >= 4;
                    bf16_t* dst = isk ? g.o1 + (size_t)row * 1024 + head * 256 + cw
                                      : g.o0 + ((((size_t)(row >> 5) * 4 + head) * 16 + (cw >> 4)) * 512 + (((cw >> 3) & 1) * 32 + (row & 31)) * 8);
                    const int dst_hi = isk ? 128 : 8 * 512;
                    u32x4 lo, hi;
                    rope_pair8(acc[ai][0][m][0], acc[ai][0][m][1], acc[ai][1][m][0], acc[ai][1][m][1], rs, (float)posr[ai][m], cw, LOG2_1E4 / 128.0f, isk ? 0.0625f : 1.0f, lo, hi);
                    *(u32x4*)dst = lo; *(u32x4*)(dst + dst_hi) = hi;
                } else {
                    bf16_t* dst = g.o2 + (size_t)row * 2048 + (pn - 8) * 256 + cw;
#pragma unroll
                    for (int bj = 0; bj < 2; ++bj) *(u32x4*)(dst + bj * 128) = pack8(acc[ai][bj][m][0], acc[ai][bj][m][1], rs);
                }
            }
    } else if (((EPI_MASK >> E_RETT) & 1) && g.epi == E_RETT) {
        const float lg2 = pm == 0 ? g.lg2a : pm == 1 ? g.lg2b : pm == 2 ? g.lg2c : g.lg2d;
#pragma unroll
        for (int bj = 0; bj < 2; ++bj) {
            const int tok0 = pn * 256 + bj * 128 + cw;
            float rs[8], pf[8];
#pragma unroll
            for (int e = 0; e < 8; ++e) { rs[e] = g.ssq_in[(size_t)(tok0 + e) * 16 + fr]; pf[e] = (float)g.pos[tok0 + e]; }
#pragma unroll
            for (int e = 0; e < 8; ++e) {
                float sm = rs[e];
                sm += __shfl_xor(sm, 1); sm += __shfl_xor(sm, 2); sm += __shfl_xor(sm, 4); sm += __shfl_xor(sm, 8);
                rs[e] = __builtin_amdgcn_rsqf(sm * (1.0f / 1024.0f) + EPS) * fexp2((float)(127 - ((tok0 + e) & 127)) * lg2) * 0.0625f;
            }
#pragma unroll
            for (int m = 0; m < 4; ++m) {
                const int i = wr * 64 + m * 16 + fr;
                const float invf = fexp2(-(float)i * (LOG2_1E4 / 128.0f));
                u32x4 lo, hi;
#pragma unroll
                for (int e2 = 0; e2 < 4; ++e2) {
                    float o0[2], o1[2];
#pragma unroll
                    for (int t = 0; t < 2; ++t) {
                        const int e = 2 * e2 + t;
                        const float v0 = acc[0][bj][m][e >> 2][e & 3] * rs[e], v1 = acc[1][bj][m][e >> 2][e & 3] * rs[e];
                        float sn, cs; sincos_rev(pf[e] * invf, sn, cs);
                        o0[t] = v0 * cs - v1 * sn; o1[t] = v1 * cs + v0 * sn;
                    }
                    lo[e2] = pk2(o0[0], o0[1]); hi[e2] = pk2(o1[0], o1[1]);
                    __builtin_amdgcn_sched_barrier(0);
                }
                *(u32x4*)(g.o0 + (size_t)(pm * 256 + i) * TH + tok0) = lo;
                *(u32x4*)(g.o0 + (size_t)(pm * 256 + 128 + i) * TH + tok0) = hi;
            }
        }
    } else if (((EPI_MASK >> E_VB) & 1) && g.epi == E_VB) {
        const bool hstat = g.lg2a > 0.f;
#pragma unroll
        for (int bj = 0; bj < 2; ++bj) {
            const int tok0 = pn * 256 + bj * 128 + cw;
            float rs[8];
#pragma unroll
            for (int e = 0; e < 8; ++e) rs[e] = hstat ? g.ssq_in[(size_t)(tok0 + e) * 16 + fr] : g.ssq_in[(size_t)(tok0 + e) * 4 + (fr & 3)];
#pragma unroll
            for (int e = 0; e < 8; ++e) {
                float sm = rs[e];
                sm += __shfl_xor(sm, 1); sm += __shfl_xor(sm, 2);
                if (hstat) { sm += __shfl_xor(sm, 4); sm += __shfl_xor(sm, 8); }
                rs[e] = __builtin_amdgcn_rsqf(sm * (hstat ? 1.0f / 1024.0f : 1.0f / 128.0f) + EPS);
            }
#pragma unroll
            for (int ai = 0; ai < 2; ++ai)
#pragma unroll
                for (int m = 0; m < 4; ++m) {
                    const int frow = pm * 256 + ai * 128 + wr * 64 + m * 16 + fr;
                    const f32x4 a = acc[ai][bj][m][0], b = acc[ai][bj][m][1];
                    u32x4 w; w.x = pk2(a[0] * rs[0], a[1] * rs[1]); w.y = pk2(a[2] * rs[2], a[3] * rs[3]);
                    w.z = pk2(b[0] * rs[4], b[1] * rs[5]); w.w = pk2(b[2] * rs[6], b[3] * rs[7]);
                    *(u32x4*)(g.o1 + (size_t)frow * TH + tok0) = w;
                }
        }
    } else if (((EPI_MASK >> E_OUT) & 1) && g.epi == E_OUT) {
#pragma unroll
        for (int ai = 0; ai < 2; ++ai)
#pragma unroll
            for (int mp = 0; mp < 2; ++mp) {
                f32x4 hv[2][2][2];
#pragma unroll
                for (int mm = 0; mm < 2; ++mm)
#pragma unroll
                    for (int bj = 0; bj < 2; ++bj) {
                        const size_t off = (size_t)(pm * 256 + ai * 128 + wr * 64 + (2 * mp + mm) * 16 + fr) * 1024 + pn * 256 + bj * 128 + cw;
                        hv[mm][bj][0] = *(const f32x4*)(g.hin + off); hv[mm][bj][1] = *(const f32x4*)(g.hin + off + 4);
                    }
#pragma unroll
                for (int mm = 0; mm < 2; ++mm) {
                    const int m = 2 * mp + mm;
                    const int row = pm * 256 + ai * 128 + wr * 64 + m * 16 + fr;
                    float ss = 0.f;
#pragma unroll
                    for (int bj = 0; bj < 2; ++bj) {
                        const size_t off = (size_t)row * 1024 + pn * 256 + bj * 128 + cw;
                        const f32x4 h0 = hv[mm][bj][0] + acc[ai][bj][m][0], h1 = hv[mm][bj][1] + acc[ai][bj][m][1];
                        *(f32x4*)(g.hout + off) = h0; *(f32x4*)(g.hout + off + 4) = h1;
                        if (g.o0) *(u32x4*)(g.o0 + off) = pack8(h0, h1, 1.0f);
                        ss += (h0.x * h0.x + h0.y * h0.y) + (h0.z * h0.z + h0.w * h0.w) + (h1.x * h1.x + h1.y * h1.y) + (h1.z * h1.z + h1.w * h1.w);
                    }
                    ss += __shfl_xor(ss, 16); ss += __shfl_xor(ss, 32);
                    if (fq == 0) g.ssq_out[(size_t)row * 16 + pn * 4 + wc] = ss;
                }
            }
    } else if (((EPI_MASK >> E_MLAIN) & 1) && g.epi == E_MLAIN) {
        row_stats(g, pm, wr, fr, fq, true, 1.0f / 1024.0f, rsr, posr);
#pragma unroll
        for (int ai = 0; ai < 2; ++ai)
#pragma unroll
            for (int m = 0; m < 4; ++m) {
                const int row = pm * 256 + ai * 128 + wr * 64 + m * 16 + fr;
                const float rs = rsr[ai][m];
                if (pn == 0) {
                    float ss = 0.f;
#pragma unroll
                    for (int bj = 0; bj < 2; ++bj) {
                        const f32x4 a = acc[ai][bj][m][0] * rs, b = acc[ai][bj][m][1] * rs;
                        *(u32x4*)(g.o0 + (size_t)row * 384 + bj * 128 + cw) = pack8(a, b, 1.0f);
                        ss += (a.x * a.x + a.y * a.y) + (a.z * a.z + a.w * a.w) + (b.x * b.x + b.y * b.y) + (b.z * b.z + b.w * b.w);
                    }
                    ss += __shfl_xor(ss, 16); ss += __shfl_xor(ss, 32);
                    if (fq == 0) g.ssq_out[(size_t)row * 4 + wc] = ss;
                } else if (pn == 1) {
                    float ss = 0.f;
                    if (wc == 0) {
                        u32x4 lo, hi;
                        rope_pair8(acc[ai][0][m][0], acc[ai][0][m][1], acc[ai][1][m][0], acc[ai][1][m][1], rs, (float)posr[ai][m], 8 * fq, LOG2_1E4 / 32.0f, 1.0f, lo, hi);
                        *(u32x4*)(g.o1 + (size_t)row * 64 + 8 * fq) = lo; *(u32x4*)(g.o1 + (size_t)row * 64 + 32 + 8 * fq) = hi;
                    } else {
                        {
                            const f32x4 a = acc[ai][0][m][0] * rs, b = acc[ai][0][m][1] * rs;
                            *(u32x4*)(g.o0 + (size_t)row * 384 + 256 + cw - 32) = pack8(a, b, 1.0f);
                            ss += (a.x * a.x + a.y * a.y) + (a.z * a.z + a.w * a.w) + (b.x * b.x + b.y * b.y) + (b.z * b.z + b.w * b.w);
                        }
                        if (wc == 1) {
                            const f32x4 a = acc[ai][1][m][0] * rs, b = acc[ai][1][m][1] * rs;
                            *(u32x4*)(g.o0 + (size_t)row * 384 + 256 + 96 + 8 * fq) = pack8(a, b, 1.0f);
                            ss += (a.x * a.x + a.y * a.y) + (a.z * a.z + a.w * a.w) + (b.x * b.x + b.y * b.y) + (b.z * b.z + b.w * b.w);
                        }
                    }
                    ss += __shfl_xor(ss, 16); ss += __shfl_xor(ss, 32);
                    if (fq == 0) g.ssq_out2[(size_t)row * 4 + wc] = ss;
                } else {
                    bf16_t* dst = g.o2 + (size_t)row * 2048 + (pn - 2) * 256 + cw;
#pragma unroll
                    for (int bj = 0; bj < 2; ++bj) *(u32x4*)(dst + bj * 128) = pack8(acc[ai][bj][m][0], acc[ai][bj][m][1], rs);
                }
            }
    } else if (((EPI_MASK >> E_QB) & 1) && g.epi == E_QB) {
        row_stats(g, pm, wr, fr, fq, false, 1.0f / 256.0f, rsr, posr);
        const float qscale = 0.07216878364870322f * LOG2E;
#pragma unroll
        for (int ai = 0; ai < 2; ++ai)
#pragma unroll
            for (int m = 0; m < 4; ++m) {
                const int row = pm * 256 + ai * 128 + wr * 64 + m * 16 + fr;
                const float rs = rsr[ai][m] * qscale;
                if (pn < 8) {
#pragma unroll
                    for (int bj = 0; bj < 2; ++bj)
                        *(u32x4*)(g.o0 + ((size_t)row * 16 + 2 * pn + bj) * 192 + cw) = pack8(acc[ai][bj][m][0], acc[ai][bj][m][1], rs);
                } else {
                    const int head = 4 * (pn - 8) + wc;
                    u32x4 lo, hi;
                    rope_pair8(acc[ai][0][m][0], acc[ai][0][m][1], acc[ai][1][m][0], acc[ai][1][m][1], rs, (float)posr[ai][m], 8 * fq, LOG2_1E4 / 32.0f, 1.0f, lo, hi);
                    bf16_t* dst = g.o0 + ((size_t)row * 16 + head) * 192 + 128 + 8 * fq;
                    *(u32x4*)dst = lo; *(u32x4*)(dst + 32) = hi;
                }
            }
    } else if (((EPI_MASK >> E_KB) & 1) && g.epi == E_KB) {
        row_stats(g, pm, wr, fr, fq, false, 1.0f / 128.0f, rsr, posr);
#pragma unroll
        for (int ai = 0; ai < 2; ++ai)
#pragma unroll
            for (int m = 0; m < 4; ++m) {
                const int row = pm * 256 + ai * 128 + wr * 64 + m * 16 + fr;
                const float rs = rsr[ai][m];
#pragma unroll
                for (int bj = 0; bj < 2; ++bj)
                    *(u32x4*)(g.o0 + ((size_t)row * 16 + 2 * pn + bj) * 128 + cw) = pack8(acc[ai][bj][m][0], acc[ai][bj][m][1], rs);
            }
    }
}

DI void gemm_phase(LAS unsigned char* lds, const GemmD& g, int tid0) {
    using namespace pg8;
    const int tid = tid0, wid = __builtin_amdgcn_readfirstlane(tid >> 6), lane = tid & 63, wr = wid >> 2, wc = wid & 3, fr = lane & 15, fq = lane >> 4;
    const int K = g.K, nt = K / BK;
    StaticOrder S; S.init(g.nM, g.nN, (int)gridDim.x, (int)blockIdx.x);
    unsigned voffA, voffB;
    { int R, C; stage_rc(tid * 16, R, C); const int Rb = (R & ~31) + perm32(R & 31);
      voffA = (unsigned)(R * g.lda + C) * 2u; voffB = (unsigned)(Rb * g.ldb + C) * 2u; }
    const size_t pvoffA = (size_t)64 * g.lda * 2, pvoffB = (size_t)64 * g.ldb * 2;
    const size_t kstep = (size_t)(BK * 2);
    const size_t hstepA = (size_t)HALF * g.lda * 2, hstepB = (size_t)HALF * g.ldb * 2;
    const size_t tstepA = 2 * hstepA, tstepB = 2 * hstepB;
    const unsigned ldsw = (unsigned)wid * 1024u;
    const int aoff = lds_byte(wr * 64 + fr, fq * 8), boff = lds_byte(wc * 32 + fr, fq * 8);
#define PG8_SA(b, h) (((b) * 2 + (h)) * HTB)
#define PG8_SB(b, h) ((4 + (b) * 2 + (h)) * HTB)
#define PG8_STAGE(bufoff, gbase, voff) do { _Pragma("unroll") for (int _i = 0; _i < 2; ++_i) \
        __builtin_amdgcn_global_load_lds((const unsigned*)((const char*)(gbase) + _i * p##voff + voff), (LAS unsigned*)(lds + (bufoff) + ldsw + _i * 8192), 16, 0, 0); } while (0)
#define PG8_LDA(dst, b, h) do { _Pragma("unroll") for (int m = 0; m < 4; ++m) _Pragma("unroll") for (int k = 0; k < 2; ++k) dst[m][k] = *(const LAS bf16x8*)(lds + PG8_SA(b, h) + aoff + m * 2048 + k * 1024); } while (0)
#define PG8_LDB(dst, b, h) do { _Pragma("unroll") for (int n = 0; n < 2; ++n) _Pragma("unroll") for (int k = 0; k < 2; ++k) dst[n][k] = *(const LAS bf16x8*)(lds + PG8_SB(b, h) + boff + n * 2048 + k * 1024); } while (0)
#define PG8_MMA(ai, bj, At, Bt) do { __builtin_amdgcn_s_setprio(1); _Pragma("unroll") for (int m = 0; m < 4; ++m) _Pragma("unroll") for (int n = 0; n < 2; ++n) _Pragma("unroll") for (int k = 0; k < 2; ++k) \
        acc[ai][bj][m][n] = __builtin_amdgcn_mfma_f32_16x16x32_bf16(Bt[n][k], At[m][k], acc[ai][bj][m][n], 0, 0, 0); __builtin_amdgcn_s_setprio(0); } while (0)
#define PG8_WAIT_V(n) asm volatile("s_waitcnt vmcnt(" #n ")" ::: "memory")
#define PG8_WAIT_L(n) asm volatile("s_waitcnt lgkmcnt(" #n ")" ::: "memory")
#define PG8_BAR __builtin_amdgcn_s_barrier()
#define PG8_SCHED __builtin_amdgcn_sched_barrier(0)
#define PG8_BTILE(pn) ((pn) + ((pn) >= g.bskip_from ? g.bskip_add : 0))
    Unit cur, nxt; int ui = 0;
    if (!S.next(0, cur)) return;
    LAS float* ktab = (LAS float*)(lds + 131072 + wid * 2048);
#define PG8_KTAB(u_) do { if (g.kscale) { \
        _Pragma("unroll 1") for (int rr_ = 0; rr_ < 2; ++rr_) { const int rl_ = lane + 64 * rr_; \
            const int grow_ = (u_).pm * 256 + (rl_ >> 6) * 128 + wr * 64 + (rl_ & 63); float rprev_ = 0.f; \
            _Pragma("unroll 2") for (int h_ = 0; h_ < 4; ++h_) { const float* p_ = g.kscale + ((size_t)grow_ * 4 + h_) * 16; \
                const f32x4 a_ = *(const f32x4*)p_, b_ = *(const f32x4*)(p_ + 4), c_ = *(const f32x4*)(p_ + 8), d_ = *(const f32x4*)(p_ + 12); \
                const float sm_ = ((a_.x + a_.y) + (a_.z + a_.w)) + ((b_.x + b_.y) + (b_.z + b_.w)) + ((c_.x + c_.y) + (c_.z + c_.w)) + ((d_.x + d_.y) + (d_.z + d_.w)); \
                const float rc_ = __builtin_amdgcn_rsqf(sm_ * (1.0f / 512.0f) + EPS); \
                if (h_ > 0) ktab[(h_ - 1) * 128 + rl_] = rprev_ / rc_; \
                rprev_ = rc_; } \
            ktab[3 * 128 + rl_] = rprev_; } \
        asm volatile("s_waitcnt lgkmcnt(0)" ::: "memory"); } } while (0)
    PG8_KTAB(cur);
    AccT acc;
    float zz = 0.f; asm volatile("" : "+v"(zz));
#pragma unroll
    for (int a = 0; a < 2; ++a)
#pragma unroll
        for (int b = 0; b < 2; ++b)
#pragma unroll
            for (int m = 0; m < 4; ++m)
#pragma unroll
                for (int n = 0; n < 2; ++n) acc[a][b][m][n] = (f32x4){zz, zz, zz, zz};
    bf16x8 At[4][2], B0[2][2], B1[2][2];
    const char* cA = (const char*)g.A + (size_t)cur.pm * tstepA; const char* cB = (const char*)g.Bt + (size_t)PG8_BTILE(cur.pn) * tstepB;
    PG8_STAGE(PG8_SB(0, 0), cB, voffB); PG8_STAGE(PG8_SA(0, 0), cA, voffA); PG8_STAGE(PG8_SB(0, 1), cB + hstepB, voffB); PG8_STAGE(PG8_SA(0, 1), cA + hstepA, voffA);
    if (wr == 1) PG8_BAR;
    PG8_WAIT_V(4); PG8_BAR;
    PG8_STAGE(PG8_SB(1, 0), cB + kstep, voffB); PG8_STAGE(PG8_SA(1, 0), cA + kstep, voffA); PG8_STAGE(PG8_SB(1, 1), cB + hstepB + kstep, voffB);
    PG8_WAIT_V(6); PG8_BAR;
    for (;;) {
        const bool has_next = S.next(ui + 1, nxt);
        const char* nA = has_next ? (const char*)g.A + (size_t)nxt.pm * tstepA : cA; const char* nB = has_next ? (const char*)g.Bt + (size_t)PG8_BTILE(nxt.pn) * tstepB : cB;
        const int seglen = g.kscale ? 8 : nt;
        for (int t0 = 0; t0 < nt; t0 += seglen) {
        if (g.kscale && t0 > 0) {
            float rt[2][4];
#pragma unroll
            for (int a = 0; a < 2; ++a)
#pragma unroll
                for (int m = 0; m < 4; ++m) rt[a][m] = ktab[((t0 >> 3) - 1) * 128 + a * 64 + m * 16 + fr];
            asm volatile("s_waitcnt lgkmcnt(0)" ::: "memory");
#pragma unroll
            for (int a = 0; a < 2; ++a)
#pragma unroll
                for (int b = 0; b < 2; ++b)
#pragma unroll
                    for (int m = 0; m < 4; ++m)
#pragma unroll
                        for (int n = 0; n < 2; ++n) acc[a][b][m][n] *= rt[a][m];
        }
        for (int t = t0; t < t0 + seglen; t += 2) {
            const bool last = (t == nt - 2);
            const char* a1 = cA + (size_t)(t + 1) * kstep;
            const char* a2 = last ? nA : cA + (size_t)(t + 2) * kstep; const char* b2 = last ? nB : cB + (size_t)(t + 2) * kstep;
            const char* a3 = a2 + kstep; const char* b3 = b2 + kstep;
            PG8_LDB(B0, 0, 0); PG8_SCHED; PG8_LDA(At, 0, 0); PG8_STAGE(PG8_SA(1, 1), a1 + hstepA, voffA);
            PG8_WAIT_L(8); PG8_BAR; PG8_WAIT_L(0); PG8_MMA(0, 0, At, B0); PG8_BAR; PG8_SCHED;
            PG8_LDB(B1, 0, 1); PG8_STAGE(PG8_SB(0, 0), b2, voffB);
            PG8_BAR; PG8_WAIT_L(0); PG8_MMA(0, 1, At, B1); PG8_BAR;
            PG8_LDA(At, 0, 1); PG8_STAGE(PG8_SA(0, 0), a2, voffA);
            PG8_BAR; PG8_WAIT_L(0); PG8_MMA(1, 0, At, B0); PG8_BAR; PG8_SCHED;
            PG8_STAGE(PG8_SB(0, 1), b2 + hstepB, voffB);
            PG8_WAIT_V(6); PG8_BAR; PG8_MMA(1, 1, At, B1); PG8_BAR;
            PG8_LDB(B0, 1, 0); PG8_SCHED; PG8_LDA(At, 1, 0); PG8_STAGE(PG8_SA(0, 1), a2 + hstepA, voffA);
            PG8_WAIT_L(8); PG8_BAR; PG8_WAIT_L(0); PG8_MMA(0, 0, At, B0); PG8_BAR; PG8_SCHED;
            PG8_LDB(B1, 1, 1); PG8_STAGE(PG8_SB(1, 0), b3, voffB);
            PG8_BAR; PG8_WAIT_L(0); PG8_MMA(0, 1, At, B1); PG8_BAR;
            PG8_LDA(At, 1, 1); PG8_STAGE(PG8_SA(1, 0), a3, voffA);
            PG8_BAR; PG8_WAIT_L(0); PG8_MMA(1, 0, At, B0); PG8_BAR; PG8_SCHED;
            PG8_STAGE(PG8_SB(1, 1), b3 + hstepB, voffB);
            PG8_WAIT_V(6); PG8_BAR; PG8_MMA(1, 1, At, B1); PG8_BAR;
        }
        }
        if (g.kscale) {
            float rt[2][4];
#pragma unroll
            for (int a = 0; a < 2; ++a)
#pragma unroll
                for (int m = 0; m < 4; ++m) rt[a][m] = ktab[3 * 128 + a * 64 + m * 16 + fr];
            asm volatile("s_waitcnt lgkmcnt(0)" ::: "memory");
#pragma unroll
            for (int a = 0; a < 2; ++a)
#pragma unroll
                for (int b = 0; b < 2; ++b)
#pragma unroll
                    for (int m = 0; m < 4; ++m)
#pragma unroll
                        for (int n = 0; n < 2; ++n) acc[a][b][m][n] *= rt[a][m];
        }
        gemm_epilogue(g, acc, cur, wr, wc, fr, fq);
        if (!has_next) break;
        PG8_KTAB(nxt);
        asm volatile("" : "+v"(zz));
#pragma unroll
        for (int a = 0; a < 2; ++a)
#pragma unroll
            for (int b = 0; b < 2; ++b)
#pragma unroll
                for (int m = 0; m < 4; ++m)
#pragma unroll
                    for (int n = 0; n < 2; ++n) acc[a][b][m][n] = (f32x4){zz, zz, zz, zz};
        cur = nxt; cA = nA; cB = nB; ++ui;
    }
    PG8_WAIT_V(0);
    if (wr == 0) PG8_BAR;
    PG8_BAR;
}

struct WJob { const float* W; const float* gain; bf16_t* dst; int K, Nsrc, Nout, Kout, koff, map; };
DI int src_col(int map, int n) {
    if (map == 0) return n;
    if (map == 1) {
        if (n < 256) return n;
        if (n < 512) { const int c = n - 256;
            if (c < 32) return 384 + c; if (c < 128) return 256 + (c - 32); if (c < 160) return 384 + 32 + (c - 128); if (c < 192) return 256 + 96 + (c - 160); return -1; }
        return 448 + (n - 512);
    }
    if (map == 2) {
        const int pn = n >> 8, c = n & 255;
        if (pn < 8) return (2 * pn + (c >> 7)) * 192 + (c & 127);
        const int cl = c & 127; return (4 * (pn - 8) + (cl >> 5)) * 192 + 128 + (cl & 31) + ((c >> 7) ? 32 : 0);
    }
    if (map == 3) return (n >> 7) * 256 + (n & 127);
    return (n >> 7) * 256 + 128 + (n & 127);
}
DI WJob get_job(const Params& P, int j) {
    WJob w; w.koff = 0; w.map = 0; w.gain = nullptr;
    if (j < 4) { const int l = j >> 1; unsigned char* base = P.ws + W_RET + (size_t)l * 16 * MiB;
        if ((j & 1) == 0) { w.W = P.ret_win[l]; w.gain = P.lnorm[2 * l]; w.dst = (bf16_t*)base; w.K = 1024; w.Nsrc = 6144; w.Nout = 6144; w.Kout = 1024; }
        else { w.W = P.ret_wout[l]; w.gain = P.ret_gn[l]; w.dst = (bf16_t*)(base + 12 * MiB); w.K = 2048; w.Nsrc = 1024; w.Nout = 1024; w.Kout = 2048; }
        return w; }
    const int jj = j - 4, l = jj / 5, k = jj % 5; unsigned char* base = P.ws + W_MLA + (size_t)l * W_MLA_SZ;
    if (k == 0) { w.W = P.mla_win[l]; w.gain = P.lnorm[2 * l + 1]; w.dst = (bf16_t*)base; w.K = 1024; w.Nsrc = 2496; w.Nout = 2560; w.Kout = 1024; w.map = 1; }
    else if (k == 1) { w.W = P.mla_wqb[l]; w.gain = P.mla_qn[l]; w.dst = (bf16_t*)(base + 5 * MiB); w.K = 256; w.Nsrc = 3072; w.Nout = 3072; w.Kout = 256; w.map = 2; }
    else if (k == 2) { w.W = P.mla_wkvb[l]; w.gain = P.mla_kvn[l]; w.dst = (bf16_t*)(base + 6 * MiB + MiB / 2); w.K = 128; w.Nsrc = 4096; w.Nout = 2048; w.Kout = 128; w.koff = 0; w.map = 3; }
    else if (k == 3) { w.W = P.mla_wkvb[l]; w.gain = P.mla_kvn[l]; w.dst = (bf16_t*)(base + 7 * MiB + MiB / 2); w.K = 128; w.Nsrc = 4096; w.Nout = 2048; w.Kout = 128; w.koff = 0; w.map = 4; }
    else { w.W = P.mla_wout[l]; w.dst = (bf16_t*)(base + 8 * MiB + MiB / 2); w.K = 2048; w.Nsrc = 1024; w.Nout = 1024; w.Kout = 2048; }
    return w;
}
DI void wprep_phase(LAS unsigned char* lds, const Params& P, int tid0) {
    const int tid = tid0, wid = tid >> 6, lane = tid & 63;
    LAS float* scr = (LAS float*)(lds + wid * 8704);
    constexpr int NJ = 14;
    constexpr int cnt[NJ] = {3072, 1024, 3072, 1024, 1280, 384, 128, 128, 1024, 1280, 384, 128, 128, 1024};
    constexpr int NTOT = 2 * (3072 + 1024) + 2 * (1280 + 384 + 128 + 128 + 1024);
    for (int it0 = blockIdx.x * 8; it0 < NTOT; it0 += gridDim.x * 8) {
        int it = it0 + wid, j = 0;
        const bool live = it < NTOT;
        if (live) {
#pragma unroll
            for (int q = 0; q < NJ - 1; ++q) if (j == q && it >= cnt[q]) { it -= cnt[q]; j = q + 1; }
        }
        j = __builtin_amdgcn_readfirstlane(j); it = __builtin_amdgcn_readfirstlane(it);
        WJob w = get_job(P, live ? j : 0);
        const int nblk = w.Nout / 32;
        const int kb = it / nblk, nb = it % nblk, k0 = 64 * kb, n0 = 32 * nb;
        if (live) {
            const int sc = src_col(w.map, n0 + (lane & 31));
#pragma unroll 8
            for (int i = 0; i < 32; ++i) {
                const int kk = 2 * i + (lane >> 5), ks = k0 + kk - w.koff;
                float v = 0.f;
                if (sc >= 0 && ks >= 0) { v = w.W[(size_t)ks * w.Nsrc + sc]; if (w.gain) v *= w.gain[ks]; }
                scr[kk * 33 + (lane & 31)] = v;
            }
        }
        __syncthreads();
        if (live) {
            const int c = lane & 7;
#pragma unroll
            for (int jn = 0; jn < 4; ++jn) { const int n = (lane >> 3) + 8 * jn; const LAS float* sp = scr + (8 * c) * 33 + n;
                u32x4 o; o.x = pk2(sp[0 * 33], sp[1 * 33]); o.y = pk2(sp[2 * 33], sp[3 * 33]); o.z = pk2(sp[4 * 33], sp[5 * 33]); o.w = pk2(sp[6 * 33], sp[7 * 33]);
                *(u32x4*)(w.dst + (size_t)(n0 + n) * w.Kout + k0 + 8 * c) = o; }
        }
        __syncthreads();
    }
}

DI void xprep_phase(const Params& P, int half, int tid0) {
    const int wid = tid0 >> 6, lane = tid0 & 63;
    const float* x = P.x + (size_t)half * TH * DM;
    bf16_t* hb = (bf16_t*)(P.ws + O_HB); float* ssq = (float*)(P.ws + (half ? O_SSQH2 : O_SSQH));
    const int rstep = gridDim.x * 8;
    for (int row = blockIdx.x * 8 + wid; row < TH; row += 2 * rstep) {
        const int row2 = row + rstep; const bool has2 = row2 < TH; const int r2 = has2 ? row2 : row;
        const f32x4* xr = (const f32x4*)(x + (size_t)row * DM) + lane; const f32x4* xr2 = (const f32x4*)(x + (size_t)r2 * DM) + lane;
        f32x4 v[4], v2[4];
#pragma unroll
        for (int j = 0; j < 4; ++j) { v[j] = xr[64 * j]; v2[j] = xr2[64 * j]; }
        float s = 0.f, s2 = 0.f;
#pragma unroll
        for (int j = 0; j < 4; ++j) { s += (v[j].x * v[j].x + v[j].y * v[j].y) + (v[j].z * v[j].z + v[j].w * v[j].w);
            s2 += (v2[j].x * v2[j].x + v2[j].y * v2[j].y) + (v2[j].z * v2[j].z + v2[j].w * v2[j].w);
            u32x2 o; o.x = pk2(v[j].x, v[j].y); o.y = pk2(v[j].z, v[j].w); *((u32x2*)(hb + (size_t)row * DM) + lane + 64 * j) = o; }
        if (has2) {
#pragma unroll
            for (int j = 0; j < 4; ++j) { u32x2 o; o.x = pk2(v2[j].x, v2[j].y); o.y = pk2(v2[j].z, v2[j].w); *((u32x2*)(hb + (size_t)r2 * DM) + lane + 64 * j) = o; }
        }
#pragma unroll
        for (int o = 1; o < 64; o <<= 1) { s += __shfl_xor(s, o); s2 += __shfl_xor(s2, o); }
        if (lane < 16) { ssq[(size_t)row * 16 + lane] = lane == 0 ? s : 0.f; if (has2) ssq[(size_t)r2 * 16 + lane] = lane == 0 ? s2 : 0.f; }
    }
}

DI void gnorm_phase(const Params& P, int tid0, bool dry) {
    bf16_t* G = (bf16_t*)(P.ws + O_G); bf16_t* Go = (bf16_t*)(P.ws + (dry ? O_DUMMY : O_G)); const float* ssqo = (const float*)(P.ws + O_SSQO);
    const size_t nvec = (size_t)TH * 2048 / 8;
    for (size_t v = (size_t)blockIdx.x * 512 + tid0; v < nvec; v += (size_t)gridDim.x * 512) {
        const int row = (int)(v >> 8), c = (int)(v & 255) * 8, head = c >> 9;
        const float rs = rstd_parts(ssqo + ((size_t)row * 4 + head) * 16, 4, 1.0f / 512.0f);
        u32x4 w = *(u32x4*)(G + (size_t)row * 2048 + c);
        w.x = pk2(bflo(w.x) * rs, bfhi(w.x) * rs); w.y = pk2(bflo(w.y) * rs, bfhi(w.y) * rs); w.z = pk2(bflo(w.z) * rs, bfhi(w.z) * rs); w.w = pk2(bflo(w.w) * rs, bfhi(w.w) * rs);
        *(u32x4*)(Go + (size_t)row * 2048 + c) = w;
    }
}
DI void final_phase(const Params& P, int half, int tid0, bool dry) {
    float* h = P.out + (size_t)half * TH * DM; float* ho = dry ? (float*)(P.ws + O_DUMMY) : h; const float* ssq = (const float*)(P.ws + O_SSQH);
    const int wid = tid0 >> 6, lane = tid0 & 63;
    f32x4 gn[4];
#pragma unroll
    for (int j = 0; j < 4; ++j) gn[j] = *((const f32x4*)P.fnorm + lane + 64 * j);
    const int rstep = gridDim.x * 8;
    for (int row = blockIdx.x * 8 + wid; row < TH; row += 2 * rstep) {
        const int row2 = row + rstep; const bool has2 = row2 < TH; const int r2 = has2 ? row2 : row;
        float sm = ssq[(size_t)row * 16 + (lane & 15)], sm2 = ssq[(size_t)r2 * 16 + (lane & 15)];
        const f32x4* xr = (const f32x4*)(h + (size_t)row * DM) + lane; const f32x4* xr2 = (const f32x4*)(h + (size_t)r2 * DM) + lane;
        f32x4 v[4], v2[4];
#pragma unroll
        for (int j = 0; j < 4; ++j) { v[j] = xr[64 * j]; v2[j] = xr2[64 * j]; }
        sm += __shfl_xor(sm, 1); sm += __shfl_xor(sm, 2); sm += __shfl_xor(sm, 4); sm += __shfl_xor(sm, 8);
        sm2 += __shfl_xor(sm2, 1); sm2 += __shfl_xor(sm2, 2); sm2 += __shfl_xor(sm2, 4); sm2 += __shfl_xor(sm2, 8);
        const float rs = __builtin_amdgcn_rsqf(sm * (1.0f / 1024.0f) + EPS), rs2 = __builtin_amdgcn_rsqf(sm2 * (1.0f / 1024.0f) + EPS);
        f32x4* yr = (f32x4*)(ho + (size_t)row * DM) + lane; f32x4* yr2 = (f32x4*)(ho + (size_t)r2 * DM) + lane;
#pragma unroll
        for (int j = 0; j < 4; ++j) yr[64 * j] = v[j] * rs * gn[j];
        if (has2) {
#pragma unroll
            for (int j = 0; j < 4; ++j) yr2[64 * j] = v2[j] * rs2 * gn[j];
        }
    }
}

DI void attn_phase(LAS unsigned char* lds, const Params& P, int tid0, bool dry) {
    const size_t gdelta = dry ? (O_DUMMY - O_G) / 2 : 0;
    const bf16_t* MQ = (const bf16_t*)(P.ws + O_MQ); const bf16_t* KN = (const bf16_t*)(P.ws + O_KN);
    const bf16_t* KR = (const bf16_t*)(P.ws + O_KROPE); const bf16_t* MVT = (const bf16_t*)(P.ws + O_MVT); bf16_t* G = (bf16_t*)(P.ws + O_G);
    const int tid = tid0, wid = __builtin_amdgcn_readfirstlane(tid >> 6), lane = tid & 63, r = lane & 31, hh = lane >> 5;
    constexpr int KST = 400, VST = 136, KBUF = 64 * KST, VBUF = 128 * VST, VOFF = 2 * KBUF;
    static_assert(VOFF + 2 * VBUF <= LDS_BYTES, "lds");
    const int nit = (int)blockIdx.x < 512 ? ((511 - (int)blockIdx.x) / (int)gridDim.x + 1) * 2 : 0;
#define ATT_DECODE(it_, B_, H_, QB_) do { const int pi_ = (int)blockIdx.x + ((it_) >> 1) * (int)gridDim.x, pl_ = pi_ & 255, bh_ = (pi_ >> 8) * 64 + (pl_ & 7) * 8 + ((pl_ >> 3) >> 2), jp_ = (pl_ >> 3) & 3; \
        QB_ = ((it_) & 1) ? jp_ : 7 - jp_; B_ = bh_ >> 4; H_ = bh_ & 15; } while (0)
    bf16x8 qf[12];
    u32x4 kreg[3], vreg[2];
    const bf16_t* knsrc; const bf16_t* krsrc; const bf16_t* vtsrc;
    int tv = tid, rr = r, h2 = hh;
    asm volatile("" : "+v"(tv), "+v"(rr), "+v"(h2));
#define ATT_SETPTR(B_, H_) do { const int skey_ = tv >> 3, sc8_ = tv & 7, sdv_ = tv >> 2, sc4_ = tv & 3; \
        knsrc = KN + (((size_t)(B_) * SEQ + skey_) * 16 + (H_)) * 128 + sc8_ * 8; krsrc = KR + ((size_t)(B_) * SEQ + skey_) * 64 + sc8_ * 8; \
        vtsrc = MVT + (size_t)((H_) * 128 + sdv_) * TH + (size_t)(B_) * SEQ + sc4_ * 8; } while (0)
#define ATT_QLOAD(B_, H_, QB_) do { const size_t tq_ = (size_t)(B_) * SEQ + (QB_) * 256 + 32 * wid + rr; \
        _Pragma("unroll") for (int kk = 0; kk < 12; ++kk) qf[kk] = *(const bf16x8*)(MQ + (tq_ * 16 + (H_)) * 192 + 16 * kk + 8 * h2); } while (0)
#define ATT_LOAD(kt) do { \
    kreg[0] = *(const u32x4*)(knsrc + (size_t)(kt) * 64 * 2048); kreg[1] = *(const u32x4*)(knsrc + (size_t)(kt) * 64 * 2048 + 64); \
    kreg[2] = *(const u32x4*)(krsrc + (size_t)(kt) * 64 * 64); \
    vreg[0] = *(const u32x4*)(vtsrc + (kt) * 64); vreg[1] = *(const u32x4*)(vtsrc + (kt) * 64 + 32); } while (0)
    int b = 0, h = 0, qb = 0;
    if (nit > 0) { ATT_DECODE(0, b, h, qb); ATT_SETPTR(b, h); ATT_QLOAD(b, h, qb); ATT_LOAD(0); }
    for (int it = 0; it < nit; ++it) {
        {
            const int nkt = 4 * (qb + 1);
            const int q0w = qb * 256 + 32 * wid;
            tv = tid; rr = r; h2 = hh;
            asm volatile("" : "+v"(tv), "+v"(rr), "+v"(h2));
            const size_t tokq = (size_t)b * SEQ + q0w + rr;
            const int skey = tv >> 3, sc8 = tv & 7, sdv = tv >> 2, sc4 = tv & 3;
            LAS unsigned char* kdst0 = lds + skey * KST;
            LAS unsigned char* vdst0 = lds + VOFF + sdv * VST + sc4 * 16;
#define ATT_STORE(buf) do { LAS unsigned char* kdst = kdst0 + (buf) * KBUF; LAS unsigned char* vdst = vdst0 + (buf) * VBUF; \
    *(LAS u32x4*)(kdst + sc8 * 16) = kreg[0]; *(LAS u32x4*)(kdst + 128 + sc8 * 16) = kreg[1]; *(LAS u32x4*)(kdst + 256 + sc8 * 16) = kreg[2]; \
    *(LAS u32x2*)(vdst) = (u32x2){vreg[0].x, vreg[0].y}; *(LAS u32x2*)(vdst + 8) = (u32x2){vreg[0].z, vreg[0].w}; \
    *(LAS u32x2*)(vdst + 64) = (u32x2){vreg[1].x, vreg[1].y}; *(LAS u32x2*)(vdst + 72) = (u32x2){vreg[1].z, vreg[1].w}; } while (0)
            __syncthreads();
            ATT_STORE(0);
            if (nkt > 1) ATT_LOAD(1);
            __syncthreads();
            f32x16 o[4];
#pragma unroll
            for (int d = 0; d < 4; ++d)
#pragma unroll
                for (int e = 0; e < 16; ++e) o[d][e] = 0.f;
            float mrun = -1e30f, lrun = 0.f;
            for (int kt = 0; kt < nkt; ++kt) {
                const int buf = kt & 1;
                if (64 * kt <= q0w + 31) {
                    f32x16 s[2];
#pragma unroll
                    for (int jt = 0; jt < 2; ++jt)
#pragma unroll
                        for (int e = 0; e < 16; ++e) s[jt][e] = 0.f;
                    {
                        bf16x8 kf[2][4];
                        const LAS unsigned char* kb = lds + buf * KBUF + r * KST + hh * 16;
#define ATT_KREAD(dst, g_) do { _Pragma("unroll") for (int u = 0; u < 4; ++u) dst[u] = *(const LAS bf16x8*)(kb + (32 * (u & 1)) * KST + (2 * (g_) + (u >> 1)) * 32); } while (0)
                        ATT_KREAD(kf[0], 0);
#pragma unroll
                        for (int gq = 0; gq < 6; ++gq) {
                            if (gq < 5) ATT_KREAD(kf[(gq + 1) & 1], gq + 1);
                            __builtin_amdgcn_sched_barrier(0);
                            __builtin_amdgcn_s_setprio(1);
#pragma unroll
                            for (int u = 0; u < 4; ++u) s[u & 1] = MFMA32(kf[gq & 1][u], qf[2 * gq + (u >> 1)], s[u & 1]);
                            __builtin_amdgcn_s_setprio(0);
                            __builtin_amdgcn_sched_barrier(0);
                        }
#undef ATT_KREAD
                    }
                    const bool diag = 64 * kt + 63 > q0w;
                    float mx = -1e30f;
#pragma unroll
                    for (int jt = 0; jt < 2; ++jt)
#pragma unroll
                        for (int e = 0; e < 16; ++e) {
                            if (diag) { const int key = 64 * kt + 32 * jt + (e & 3) + 8 * (e >> 2) + 4 * hh; if (key > q0w + r) s[jt][e] = -1e30f; }
                            mx = fmaxf(mx, s[jt][e]);
                        }
                    mx = fmaxf(mx, __shfl_xor(mx, 32));
                    if (__builtin_amdgcn_ballot_w64(mx > mrun + 8.0f) != 0ull) {
                        const float mnew = fmaxf(mrun, mx), alpha = fexp2(mrun - mnew);
                        mrun = mnew; lrun *= alpha;
#pragma unroll
                        for (int d = 0; d < 4; ++d)
#pragma unroll
                            for (int e = 0; e < 16; ++e) o[d][e] *= alpha;
                    }
                    float ls = 0.f;
#pragma unroll
                    for (int jt = 0; jt < 2; ++jt)
#pragma unroll
                        for (int e = 0; e < 16; ++e) { const float p = fexp2(s[jt][e] - mrun); s[jt][e] = p; ls += p; }
                    lrun += ls;
                    bf16x8 pf[2][2];
#pragma unroll
                    for (int jt = 0; jt < 2; ++jt) { pf[jt][0] = pack_step(s[jt], 0); pf[jt][1] = pack_step(s[jt], 1); }
                    {
                        bf16x8 vf[2][2];
                        const LAS unsigned char* vbp = lds + VOFF + buf * VBUF + r * VST + hh * 8;
#define ATT_VREAD(dst, g_) do { _Pragma("unroll") for (int u = 0; u < 2; ++u) { const LAS unsigned char* vp = vbp + (32 * ((g_) >> 1)) * VST + (2 * ((g_) & 1) + u) * 32; \
        const s16x4 lo = *(const LAS s16x4*)vp, hi = *(const LAS s16x4*)(vp + 16); dst[u] = __builtin_shufflevector(lo, hi, 0, 1, 2, 3, 4, 5, 6, 7); } } while (0)
                        ATT_VREAD(vf[0], 0);
#pragma unroll
                        for (int g8 = 0; g8 < 8; ++g8) {
                            if (g8 < 7) ATT_VREAD(vf[(g8 + 1) & 1], g8 + 1);
                            __builtin_amdgcn_sched_barrier(0);
                            __builtin_amdgcn_s_setprio(1);
#pragma unroll
                            for (int u = 0; u < 2; ++u) o[g8 >> 1] = MFMA32(vf[g8 & 1][u], pf[g8 & 1][u], o[g8 >> 1]);
                            __builtin_amdgcn_s_setprio(0);
                            __builtin_amdgcn_sched_barrier(0);
                        }
#undef ATT_VREAD
                    }
                }
                if (kt + 1 < nkt) ATT_STORE(buf ^ 1);
                if (kt + 2 < nkt) ATT_LOAD(kt + 2);
                __syncthreads();
            }
            int nb = b, nh = h, nqb = qb;
            if (it + 1 < nit) { ATT_DECODE(it + 1, nb, nh, nqb); ATT_SETPTR(nb, nh); ATT_QLOAD(nb, nh, nqb); ATT_LOAD(0); }
            lrun += __shfl_xor(lrun, 32);
            const float inv = 1.0f / lrun;
            u32x2 gt[4][4];
#pragma unroll
            for (int d = 0; d < 4; ++d)
#pragma unroll
                for (int g4 = 0; g4 < 4; ++g4) gt[d][g4] = *(const u32x2*)(G + tokq * 2048 + h * 128 + 32 * d + 8 * g4 + 4 * h2);
#pragma unroll
            for (int d = 0; d < 4; ++d)
#pragma unroll
                for (int g4 = 0; g4 < 4; ++g4) {
                    bf16_t* gp = G + tokq * 2048 + h * 128 + 32 * d + 8 * g4 + 4 * h2;
                    u32x2 w;
                    w.x = pk2(o[d][4 * g4 + 0] * inv * silu(bflo(gt[d][g4].x)), o[d][4 * g4 + 1] * inv * silu(bfhi(gt[d][g4].x)));
                    w.y = pk2(o[d][4 * g4 + 2] * inv * silu(bflo(gt[d][g4].y)), o[d][4 * g4 + 3] * inv * silu(bfhi(gt[d][g4].y)));
                    *(u32x2*)(gp + gdelta) = w;
                }
            b = nb; h = nh; qb = nqb;
        }
    }
#undef ATT_LOAD
#undef ATT_STORE
#undef ATT_DECODE
#undef ATT_SETPTR
#undef ATT_QLOAD
}

DI void scan_phase(LAS unsigned char* lds, const Params& P, int tid0, bool dry) {
    const size_t gdelta = dry ? (O_DUMMY - O_G) / 2 : 0;
    const int skip = dry ? SCAN_SKIP : 0;
    const bf16_t* RQ = (const bf16_t*)(P.ws + O_RQ); const bf16_t* RK = (const bf16_t*)(P.ws + O_RK);
    const bf16_t* VT = (const bf16_t*)(P.ws + O_RVT);
    bf16_t* G = (bf16_t*)(P.ws + O_G); float* SSQO = (float*)(P.ws + O_SSQO);
    const int tid = tid0, wid = __builtin_amdgcn_readfirstlane(tid >> 6), lane = tid & 63, r = lane & 31, hh = lane >> 5;
    constexpr int KS = 528, TS = 272, SLOT = 64 * KS, VTO = 2 * SLOT, VTB = 64 * TS, VDO = VTO + VTB, RST = 528, RIO = VDO + VTB, RIB = 64 * RST;
    static_assert(RIO + RIB <= LDS_BYTES, "lds");
    const int ib = wid < 4 ? wid : 7 - wid, vh = wid >> 2;
    const int dbw = wid & 3, vb = wid >> 2;
    const int trq = (lane & 15) >> 2, trp = lane & 3, trb = (lane >> 4) & 1;
    for (int it = blockIdx.x; it < 256; it += gridDim.x) {
        const int bhx = (it & 7) * 4 + ((it >> 3) >> 3), sl = (it >> 3) & 7, b = bhx >> 2, h = bhx & 3;
        const int v0 = h * 512 + sl * 64;
        const float lg2 = __builtin_log2f(1.0f - fexp2(-5.0f - (float)h));
        const float cdec = fexp2(128.0f * lg2);
        __syncthreads();
        { unsigned zu = 0u; asm volatile("" : "+v"(zu));
          for (int i = tid; i < RIB / 16; i += 512) *(LAS u32x4*)(lds + RIO + i * 16) = (u32x4){zu, zu, zu, zu}; }
        u32x4 stg[4], vstg[2];
#define SC_LOADK(n_, jh_) do { _Pragma("unroll") for (int i = 0; i < 4; ++i) { const int p = tv + 512 * i; \
        stg[i] = *(const u32x4*)(RK + ((size_t)b * SEQ + (n_) * 128 + (jh_) * 64 + (p >> 5)) * 1024 + h * 256 + (p & 31) * 8); } } while (0)
#define SC_STOREK(slot) do { _Pragma("unroll") for (int i = 0; i < 4; ++i) { const int p = tv + 512 * i; \
        *(LAS u32x4*)(lds + (slot) * SLOT + (p >> 5) * KS + (p & 31) * 16) = stg[i]; } } while (0)
#define SC_VLOAD(n_) do { _Pragma("unroll") for (int i = 0; i < 2; ++i) { const int p = tv + 512 * i, row = p >> 4, ch = p & 15; \
        vstg[i] = *(const u32x4*)(VT + (size_t)(v0 + row) * TH + (size_t)b * SEQ + (n_) * 128 + ch * 8); } } while (0)
#define SC_VSTORE() do { _Pragma("unroll") for (int i = 0; i < 2; ++i) { const int p = tv + 512 * i, row = p >> 4, ch = p & 15; \
        *(LAS u32x4*)(lds + VTO + row * TS + ch * 16) = vstg[i]; \
        u32x4 dv_; const float e0_ = (float)(127 - 8 * ch); \
        dv_.x = pk2(bflo(vstg[i].x) * fexp2((e0_ - 0.f) * lg2), bfhi(vstg[i].x) * fexp2((e0_ - 1.f) * lg2)); \
        dv_.y = pk2(bflo(vstg[i].y) * fexp2((e0_ - 2.f) * lg2), bfhi(vstg[i].y) * fexp2((e0_ - 3.f) * lg2)); \
        dv_.z = pk2(bflo(vstg[i].z) * fexp2((e0_ - 4.f) * lg2), bfhi(vstg[i].z) * fexp2((e0_ - 5.f) * lg2)); \
        dv_.w = pk2(bflo(vstg[i].w) * fexp2((e0_ - 6.f) * lg2), bfhi(vstg[i].w) * fexp2((e0_ - 7.f) * lg2)); \
        *(LAS u32x4*)(lds + VDO + row * TS + ch * 16) = dv_; } } while (0)
        int tv = tid, rr = r, h2 = hh;
        asm volatile("" : "+v"(tv), "+v"(rr), "+v"(h2));
        SC_LOADK(0, 0); SC_STOREK(0); SC_VLOAD(0); SC_VSTORE();
        __syncthreads();
        f32x16 X0, X1, oi;
        bf16x8 qa[8], qb[8];
#define SC_QLOAD(dst, n_, kh_) do { _Pragma("unroll") for (int kk = 0; kk < 8; ++kk) \
        dst[kk] = *(const bf16x8*)(RQ + (((((size_t)b * SEQ + (n_) * 128 + 32 * ib) >> 5) * 4 + h) * 16 + 8 * (kh_) + kk) * 512 + (h2 * 32 + rr) * 8); } while (0)
        SC_QLOAD(qa, 0, 0);
#pragma unroll
        for (int e = 0; e < 16; ++e) { X0[e] = 0.f; X1[e] = 0.f; oi[e] = 0.f; }
        for (int gs = 0; gs < 32; ++gs) {
            const int n = gs >> 1, s = gs & 1;
            const size_t tokb = (size_t)b * SEQ + n * 128;
            int iq = 32 * ib + r;
            tv = tid; rr = r; h2 = hh;
            asm volatile("" : "+v"(iq), "+v"(tv), "+v"(rr), "+v"(h2));
            if (s == 0) SC_LOADK(n, 1);
            else if (n < 15) { SC_LOADK(n + 1, 0); SC_VLOAD(n + 1); }
            if (!(skip & 16)) SC_QLOAD(qb, n, 1);
            {
                const bool act = 2 * s <= ib, two = 2 * s + 1 <= ib;
                f32x16 st[2];
#pragma unroll
                for (int jj = 0; jj < 2; ++jj)
#pragma unroll
                    for (int e = 0; e < 16; ++e) st[jj][e] = 0.f;
                if (s == 0) {
#pragma unroll
                    for (int e = 0; e < 16; ++e) oi[e] = 0.f;
                }
                {
                    bf16x8 fk0[1][2], fk1[1][2], fr[1][2];
                    const LAS unsigned char* kb0 = lds + s * SLOT + r * KS + hh * 16;
                    const LAS unsigned char* rb0 = lds + RIO + (32 * vh + r) * RST + hh * 16;
#define SC_FREAD(bi, g_) do { _Pragma("unroll") for (int u = 0; u < 2; ++u) { \
        fk0[bi][u] = *(const LAS bf16x8*)(kb0 + (2 * (g_) + u) * 32); fk1[bi][u] = *(const LAS bf16x8*)(kb0 + 32 * KS + (2 * (g_) + u) * 32); \
        fr[bi][u] = *(const LAS bf16x8*)(rb0 + (2 * (g_) + u) * 32); } } while (0)
#pragma unroll
                    for (int g8 = 0; g8 < 8; ++g8) {
                        SC_FREAD(0, g8);
                        __builtin_amdgcn_sched_barrier(0);
#pragma unroll
                        for (int u = 0; u < 2; ++u) {
                            const int ks = 2 * g8 + u;
                            const bf16x8 q = ks < 8 ? qa[ks & 7] : qb[ks & 7];
                            if (act && !(skip & 1)) st[0] = MFMA32(fk0[0][u], q, st[0]);
                            if (two && !(skip & 1)) st[1] = MFMA32(fk1[0][u], q, st[1]);
                            if (s == 0 && !(skip & 2)) oi = MFMA32(fr[0][u], q, oi);
                        }
                        __builtin_amdgcn_sched_barrier(0);
                    }
#undef SC_FREAD
                }
                if (s == 1 && n < 15 && !(skip & 4)) SC_QLOAD(qa, n + 1, 0);
                if (s == 0) {
                    const float qd = fexp2((float)(iq + 1) * lg2);
#pragma unroll
                    for (int e = 0; e < 16; ++e) oi[e] *= qd;
                }
                if (act) {
#pragma unroll
                    for (int jj = 0; jj < 2; ++jj)
                        if (jj == 0 || two) {
                            const int jt = 2 * s + jj;
#pragma unroll
                            for (int e = 0; e < 16; ++e) { const int j = 32 * jt + (e & 3) + 8 * (e >> 2) + 4 * h2;
                                st[jj][e] = j <= iq ? st[jj][e] * fexp2((float)(iq - j) * lg2) : 0.f; }
#pragma unroll
                            for (int si = 0; si < 2; ++si) {
                                const bf16x8 pf = pack_step(st[jj], si);
                                const LAS unsigned char* vp = lds + VTO + (32 * vh + r) * TS + (32 * jt + 16 * si + 4 * hh) * 2;
                                const s16x4 lo = *(const LAS s16x4*)vp, hi = *(const LAS s16x4*)(vp + 16);
                                const bf16x8 vf = __builtin_shufflevector(lo, hi, 0, 1, 2, 3, 4, 5, 6, 7);
                                oi = MFMA32(vf, pf, oi);
                            }
                        }
                }
            }
            if (s == 0) {
                SC_STOREK(1);
                __syncthreads();
            } else {
                if (!(skip & 8)) {
                    float ss = 0.f;
#pragma unroll
                    for (int e = 0; e < 16; ++e) ss += oi[e] * oi[e];
                    ss += __shfl_xor(ss, 32);
                    const size_t tok = tokb + iq;
                    if (h2 == 0) SSQO[(tok * 4 + h) * 16 + sl * 2 + vh] = ss;
                    u32x2 gts[4];
#pragma unroll
                    for (int g4 = 0; g4 < 4; ++g4) gts[g4] = *(const u32x2*)(G + tok * 2048 + v0 + 32 * vh + 8 * g4 + 4 * h2);
#pragma unroll
                    for (int g4 = 0; g4 < 4; ++g4) {
                        bf16_t* gp = G + tok * 2048 + v0 + 32 * vh + 8 * g4 + 4 * h2;
                        const u32x2 gt = gts[g4];
                        u32x2 w;
                        w.x = pk2(oi[4 * g4 + 0] * silu(bflo(gt.x)), oi[4 * g4 + 1] * silu(bfhi(gt.x)));
                        w.y = pk2(oi[4 * g4 + 2] * silu(bflo(gt.y)), oi[4 * g4 + 3] * silu(bfhi(gt.y)));
                        *(u32x2*)(gp + gdelta) = w;
                    }
                }
                if (n < 15 && !(skip & 4)) {
#pragma unroll
                    for (int e = 0; e < 16; ++e) { X0[e] *= cdec; X1[e] *= cdec; }
#pragma unroll
                    for (int kk = 0; kk < 8; ++kk) {
                        const LAS unsigned char* kp = lds + (kk >> 2) * SLOT + (16 * (kk & 3) + 8 * hh + trq) * KS + (32 * dbw + 16 * trb + 4 * trp) * 2;
                        const s16x4 t0 = __builtin_amdgcn_ds_read_tr16_b64_v4i16((LAS s16x4*)kp);
                        const s16x4 t1 = __builtin_amdgcn_ds_read_tr16_b64_v4i16((LAS s16x4*)(kp + 4 * KS));
                        const s16x4 t2 = __builtin_amdgcn_ds_read_tr16_b64_v4i16((LAS s16x4*)(kp + 256));
                        const s16x4 t3 = __builtin_amdgcn_ds_read_tr16_b64_v4i16((LAS s16x4*)(kp + 256 + 4 * KS));
                        const bf16x8 af0 = __builtin_shufflevector(t0, t1, 0, 1, 2, 3, 4, 5, 6, 7), af1 = __builtin_shufflevector(t2, t3, 0, 1, 2, 3, 4, 5, 6, 7);
                        const bf16x8 bf = *(const LAS bf16x8*)(lds + VDO + (32 * vb + r) * TS + (16 * kk + 8 * hh) * 2);
                        X0 = MFMA32(af0, bf, X0);
                        X1 = MFMA32(af1, bf, X1);
                    }
#pragma unroll
                    for (int g4 = 0; g4 < 4; ++g4) {
                        u32x2 w0, w1; w0.x = pk2(X0[4 * g4 + 0], X0[4 * g4 + 1]); w0.y = pk2(X0[4 * g4 + 2], X0[4 * g4 + 3]);
                        w1.x = pk2(X1[4 * g4 + 0], X1[4 * g4 + 1]); w1.y = pk2(X1[4 * g4 + 2], X1[4 * g4 + 3]);
                        *(LAS u32x2*)(lds + RIO + (32 * vb + r) * RST + (32 * dbw + 8 * g4 + 4 * hh) * 2) = w0;
                        *(LAS u32x2*)(lds + RIO + (32 * vb + r) * RST + (128 + 32 * dbw + 8 * g4 + 4 * hh) * 2) = w1;
                    }
                }
                __syncthreads();
                if (n < 15) { SC_STOREK(0); SC_VSTORE(); }
                __syncthreads();
            }
        }
#undef SC_LOADK
#undef SC_STOREK
#undef SC_VLOAD
#undef SC_VSTORE
#undef SC_QLOAD
    }
}

#define XB_TMO      128
#define XB_XCNT(j)  (256  + 64 * (j))
#define XB_XSUB(j)  (1280 + 64 * (j))
#define XB_XGEN(j)  (2304 + 64 * (j))
#define XB_TOP      3328
#define XB_TOPGEN   3392
#define XCD_BAR_WORDS 3456
#define XB_SPIN_CAP (1u << 18)
DI unsigned xb_ld(unsigned* p)              { return __hip_atomic_load(p, __ATOMIC_RELAXED, __HIP_MEMORY_SCOPE_AGENT); }
DI unsigned xb_add(unsigned* p, unsigned v) { return __hip_atomic_fetch_add(p, v, __ATOMIC_RELAXED, __HIP_MEMORY_SCOPE_AGENT); }
DI unsigned xb_xcc_id() { return (unsigned)__builtin_amdgcn_s_getreg((3 << 11) | 20) & 0xFu; }
#define XB_SPIN(cond, bar) do { while (cond) __builtin_amdgcn_s_sleep(1); } while (0)
DI void xcd_barrier_complete(unsigned* bar, unsigned x, unsigned& nloc, unsigned& nx) {
    const unsigned G = gridDim.x;
    unsigned sum, cnt, mine;
    for (;;) {
        sum = 0u; cnt = 0u; mine = 0u;
#pragma unroll
        for (unsigned j = 0; j < 16; ++j) { const unsigned c = xb_ld(&bar[XB_XCNT(j)]); sum += c; cnt += (c > 0u) ? 1u : 0u; mine = (j == x) ? c : mine; }
        if (sum == G) break;
        __builtin_amdgcn_s_sleep(1);
    }
    nloc = mine > 0u ? mine : 1u; nx = cnt > 0u ? cnt : 1u;
}
DI void xcd_barrier(unsigned* bar, unsigned x, volatile LAS unsigned* st, bool leader_thread) {
    asm volatile("s_waitcnt vmcnt(0)" ::: "memory");
    __syncthreads();
    if (leader_thread) {
        __builtin_amdgcn_s_waitcnt(0);
        unsigned nloc = st[0], nx = st[1];
        if (nloc == 0u) { xcd_barrier_complete(bar, x, nloc, nx); st[0] = nloc; st[1] = nx; }
        const unsigned old = xb_add(&bar[XB_XSUB(x)], 1u);
        const unsigned gen = old / nloc;
        if (old + 1u == (gen + 1u) * nloc) {
            __builtin_amdgcn_fence(__ATOMIC_RELEASE, "agent");
            asm volatile("s_waitcnt vmcnt(0)" ::: "memory");
            const unsigned og = xb_add(&bar[XB_TOP], 1u);
            const unsigned tg = og / nx;
            if (og + 1u == (tg + 1u) * nx) xb_add(&bar[XB_TOPGEN], 1u);
            else XB_SPIN(xb_ld(&bar[XB_TOPGEN]) == tg, bar);
            __builtin_amdgcn_fence(__ATOMIC_ACQUIRE, "agent");
            xb_add(&bar[XB_XGEN(x)], 1u);
            asm volatile("s_waitcnt vmcnt(0)" ::: "memory");
        } else {
            XB_SPIN(xb_ld(&bar[XB_XGEN(x)]) == gen, bar);
            __builtin_amdgcn_fence(__ATOMIC_ACQUIRE, "agent");
            asm volatile("s_waitcnt vmcnt(0)" ::: "memory");
        }
    }
    __syncthreads();
}

constexpr int NPHASES = 37;

DI int phase_kind(int ph) {
    if (ph == 0) return 0;
    const int q = (ph - 1) % 18; if (q == 0) return 3; if (q == 17) return 0;
    const int l = (q - 1) >> 2, s = (q - 1) & 3;
    if ((l & 1) == 0) return s == 0 ? 1 : s == 1 ? 2 : s == 2 ? 3 : 4;
    return s == 0 ? 5 : s == 1 ? 6 : s == 2 ? 7 : 4;
}
DI void run_phase(LAS unsigned char* lds, const Params& P, int ph, int wave_s, bool dry) {
    int tid0;
    asm volatile("v_mbcnt_lo_u32_b32 %0, -1, 0\n\tv_mbcnt_hi_u32_b32 %0, -1, %0" : "=v"(tid0));
    tid0 += wave_s * 64;
    if (ph == 0) { wprep_phase(lds, P, tid0); xprep_phase(P, 0, tid0); return; }
    const int half = (ph - 1) / 18, q = (ph - 1) % 18;
    if (q == 0) return;
    if (q == 17) { final_phase(P, half, tid0, dry); if (half == 0 && !dry) xprep_phase(P, 1, tid0); return; }
    const int l = (q - 1) >> 2, s = (q - 1) & 3;
    unsigned char* ws = P.ws;
    const int* pos = P.pos + (size_t)half * TH;
    if ((l & 1) == 0) {
        const int li = l >> 1;
        unsigned char* wb = ws + W_RET + (size_t)li * 16 * MiB;
        if (s == 1) { if (EN_SCAN) scan_phase(lds, P, tid0, dry); return; }
        if (s == 2) { gnorm_phase(P, tid0, dry); return; }
        const int ng = s == 0 ? 2 : 1;
        for (int gi = 0; gi < ng; ++gi) {
            GemmD g{};
            g.pos = pos; g.ssq_in = (const float*)(ws + ((half == 1 && l == 0) ? O_SSQH2 : O_SSQH));
            if (s == 0 && gi == 0) {
                g.A = (const bf16_t*)(ws + O_HB); g.Bt = (const bf16_t*)wb; g.lda = 1024; g.ldb = 1024; g.K = 1024; g.nM = 64; g.nN = 16; g.bskip_from = 8; g.bskip_add = 8; g.epi = E_RETQG;
                g.o0 = (bf16_t*)(ws + O_RQ); g.o1 = (bf16_t*)(ws + O_RK); g.o2 = (bf16_t*)(ws + O_G);
            } else if (s == 0) {
                g.A = (const bf16_t*)wb + (size_t)2048 * 1024; g.Bt = (const bf16_t*)(ws + O_HB); g.lda = 1024; g.ldb = 1024; g.K = 1024; g.nM = 8; g.nN = 64; g.bskip_from = 1 << 30; g.epi = E_VB;
                g.o1 = (bf16_t*)(ws + O_RVT); g.lg2a = 1.0f;
            } else {
                g.A = (const bf16_t*)(ws + O_G); g.Bt = (const bf16_t*)(wb + 12 * MiB); g.lda = 2048; g.ldb = 2048; g.K = 2048; g.nM = 64; g.nN = 4; g.bskip_from = 1 << 30; g.epi = E_OUT;
                g.kscale = (const float*)(ws + O_SSQO);
                g.hin = (l == 0 ? P.x : P.out) + (size_t)half * TH * DM; g.hout = P.out + (size_t)half * TH * DM;
                g.o0 = (bf16_t*)(ws + O_HB); g.ssq_out = (float*)(ws + O_SSQH);
                if (dry) { g.hout = (float*)(ws + O_DUMMY); g.o0 = (bf16_t*)(ws + O_DUMMY + 64 * MiB); g.ssq_out = (float*)(ws + O_DUMMY + 96 * MiB); }
            }
            if (EN_GEMM) gemm_phase(lds, g, tid0);
        }
    } else {
        const int li = l >> 1;
        unsigned char* wb = ws + W_MLA + (size_t)li * W_MLA_SZ;
        if (s == 2) { if (EN_ATTN) attn_phase(lds, P, tid0, dry); return; }
        const int ng = s == 1 ? 3 : 1;
        for (int gi = 0; gi < ng; ++gi) {
            GemmD g{};
            g.pos = pos; g.bskip_from = 1 << 30;
            if (s == 0) {
                g.A = (const bf16_t*)(ws + O_HB); g.Bt = (const bf16_t*)wb; g.lda = 1024; g.ldb = 1024; g.K = 1024; g.nM = 64; g.nN = 10; g.epi = E_MLAIN;
                g.ssq_in = (const float*)(ws + O_SSQH); g.o0 = (bf16_t*)(ws + O_LAT); g.o1 = (bf16_t*)(ws + O_KROPE); g.o2 = (bf16_t*)(ws + O_G);
                g.ssq_out = (float*)(ws + O_SSQQ); g.ssq_out2 = (float*)(ws + O_SSQKV);
            } else if (s == 1 && gi == 0) {
                g.A = (const bf16_t*)(ws + O_LAT); g.Bt = (const bf16_t*)(wb + 5 * MiB); g.lda = 384; g.ldb = 256; g.K = 256; g.nM = 64; g.nN = 12; g.epi = E_QB;
                g.ssq_in = (const float*)(ws + O_SSQQ); g.o0 = (bf16_t*)(ws + O_MQ);
            } else if (s == 1 && gi == 1) {
                g.A = (const bf16_t*)(ws + O_LAT) + 256; g.Bt = (const bf16_t*)(wb + 6 * MiB + MiB / 2); g.lda = 384; g.ldb = 128; g.K = 128; g.nM = 64; g.nN = 8; g.epi = E_KB;
                g.ssq_in = (const float*)(ws + O_SSQKV); g.o0 = (bf16_t*)(ws + O_KN);
            } else if (s == 1) {
                g.A = (const bf16_t*)(wb + 7 * MiB + MiB / 2); g.Bt = (const bf16_t*)(ws + O_LAT) + 256; g.lda = 128; g.ldb = 384; g.K = 128; g.nM = 8; g.nN = 64; g.epi = E_VB;
                g.ssq_in = (const float*)(ws + O_SSQKV); g.o1 = (bf16_t*)(ws + O_MVT);
            } else {
                g.A = (const bf16_t*)(ws + O_G); g.Bt = (const bf16_t*)(wb + 8 * MiB + MiB / 2); g.lda = 2048; g.ldb = 2048; g.K = 2048; g.nM = 64; g.nN = 4; g.epi = E_OUT;
                g.hin = P.out + (size_t)half * TH * DM; g.hout = P.out + (size_t)half * TH * DM;
                g.o0 = l == 3 ? nullptr : (bf16_t*)(ws + O_HB); g.ssq_out = (float*)(ws + O_SSQH);
                if (dry) { g.hout = (float*)(ws + O_DUMMY); g.o0 = (bf16_t*)(ws + O_DUMMY + 64 * MiB); g.ssq_out = (float*)(ws + O_DUMMY + 96 * MiB); }
            }
            if (EN_GEMM) gemm_phase(lds, g, tid0);
        }
    }
}

__global__ void __launch_bounds__(512, 2) trunk_megakernel(Params P) {
    extern __shared__ __attribute__((aligned(16))) unsigned char shm[];
    LAS unsigned char* lds = (LAS unsigned char*)shm;
    cg::grid_group grid = cg::this_grid();
    const int wave_s = __builtin_amdgcn_readfirstlane((int)(threadIdx.x >> 6));
    volatile LAS unsigned* st = (volatile LAS unsigned*)(lds + LDS_BYTES);
    unsigned* bar = (unsigned*)(P.ws + O_BAR);
    const unsigned xcc = xb_xcc_id();
    const bool use_xb = P.ph_hi - P.ph_lo > 1;
    if (use_xb) {
        if (threadIdx.x == 0) { st[0] = 0u; st[1] = 0u; (void)xb_add(&bar[XB_XCNT(xcc)], 1u); }
        __syncthreads();
    }
    const int ph_hi = __builtin_amdgcn_readfirstlane(P.ph_hi), ph_lo = __builtin_amdgcn_readfirstlane(P.ph_lo);
    int ph = ph_lo;
    if (ph < ph_hi) for (;;) {
        int nrep = (PROBE_DUP && ((PROBE_DUP >> phase_kind(ph)) & 2)) ? 2 : 1;
        if (phase_kind(ph) == 3) nrep = 0;
        if (nrep > 0) for (;;) {
            --nrep;
            run_phase(lds, P, ph, wave_s, nrep > 0);
            if (nrep > 0 || ph + 1 < ph_hi) {
                if (ph_lo < 0) grid.sync();
                else {
                    int l0; asm volatile("v_mbcnt_lo_u32_b32 %0, -1, 0\n\tv_mbcnt_hi_u32_b32 %0, -1, %0" : "=v"(l0));
                    for (int k = 0; k < 1 + (PROBE_DUP & 1); ++k) xcd_barrier(bar, xcc, st, wave_s == 0 && l0 == 0);
                }
            }
            nrep = __builtin_amdgcn_readfirstlane(nrep);
            if (nrep <= 0) break;
        }
        ph = __builtin_amdgcn_readfirstlane(ph + 1);
        if (ph >= ph_hi) break;
    }
}

extern "C" void kernel_launch(void* const* d_in, const int* in_sizes, int n_in, void* d_out, int out_size, void* d_ws, size_t ws_size, hipStream_t stream) {
    static int grid_blocks = 0;
    if (grid_blocks == 0) {
        if (n_in != 25 || ws_size < WS_NEED) { fprintf(stderr, "kernel_launch: unexpected n_in %d / ws %zu\n", n_in, ws_size); grid_blocks = -1; return; }
        int dev = 0, cus = 0, per_cu = 0;
        hipGetDevice(&dev);
        hipDeviceGetAttribute(&cus, hipDeviceAttributeMultiprocessorCount, dev);
        if (hipFuncSetAttribute((const void*)trunk_megakernel, hipFuncAttributeMaxDynamicSharedMemorySize, LDS_BYTES + 16) != hipSuccess) { fprintf(stderr, "hipFuncSetAttribute failed\n"); grid_blocks = -1; return; }
        hipOccupancyMaxActiveBlocksPerMultiprocessor(&per_cu, (const void*)trunk_megakernel, 512, LDS_BYTES + 16);
        if (per_cu < 1) per_cu = 1;
        if (per_cu > 1) per_cu = 1;
        grid_blocks = cus * per_cu;
        (void)hipGetLastError();
    }
    if (grid_blocks < 0) return;
    Params p{};
    p.x = (const float*)d_in[0]; p.pos = (const int*)d_in[1];
    p.lnorm[0] = (const float*)d_in[2]; p.ret_win[0] = (const float*)d_in[3]; p.ret_gn[0] = (const float*)d_in[4]; p.ret_wout[0] = (const float*)d_in[5];
    p.lnorm[1] = (const float*)d_in[6]; p.mla_win[0] = (const float*)d_in[7]; p.mla_qn[0] = (const float*)d_in[8]; p.mla_wqb[0] = (const float*)d_in[9];
    p.mla_kvn[0] = (const float*)d_in[10]; p.mla_wkvb[0] = (const float*)d_in[11]; p.mla_wout[0] = (const float*)d_in[12];
    p.lnorm[2] = (const float*)d_in[13]; p.ret_win[1] = (const float*)d_in[14]; p.ret_gn[1] = (const float*)d_in[15]; p.ret_wout[1] = (const float*)d_in[16];
    p.lnorm[3] = (const float*)d_in[17]; p.mla_win[1] = (const float*)d_in[18]; p.mla_qn[1] = (const float*)d_in[19]; p.mla_wqb[1] = (const float*)d_in[20];
    p.mla_kvn[1] = (const float*)d_in[21]; p.mla_wkvb[1] = (const float*)d_in[22]; p.mla_wout[1] = (const float*)d_in[23];
    p.fnorm = (const float*)d_in[24];
    p.out = (float*)d_out; p.ws = (unsigned char*)d_ws;
#if MULTI_LAUNCH
    for (int ph = 0; ph < NPHASES; ++ph) {
        p.ph_lo = ph; p.ph_hi = ph + 1;
        hipLaunchKernelGGL(trunk_megakernel, dim3(grid_blocks), dim3(512), LDS_BYTES + 16, stream, p);
    }
#else
    p.ph_lo = 0; p.ph_hi = NPHASES;
    if (hipMemsetAsync((char*)d_ws + O_BAR, 0, XCD_BAR_WORDS * 4, stream) != hipSuccess) { fprintf(stderr, "memset failed\n"); return; }
    void* args[] = {&p};
    hipError_t e = hipLaunchCooperativeKernel((const void*)trunk_megakernel, dim3(grid_blocks), dim3(512), args, LDS_BYTES + 16, stream);
    if (e != hipSuccess) fprintf(stderr, "cooperative launch failed: %s (grid %d)\n", hipGetErrorString(e), grid_blocks);
#endif
}
```

```cpp
#include <hip/hip_runtime.h>
#include <hip/hip_cooperative_groups.h>
#include <cstdio>
namespace cg = cooperative_groups;

#ifndef MULTI_LAUNCH
#define MULTI_LAUNCH 0
#endif

#ifndef PROBE_DUP
#define PROBE_DUP 0
#endif
#ifndef SCAN_SKIP
#define SCAN_SKIP 0
#endif
#ifndef EPI_MASK
#define EPI_MASK 127
#endif
#ifndef EN_GEMM
#define EN_GEMM 1
#endif
#ifndef EN_ATTN
#define EN_ATTN 1
#endif
#ifndef EN_SCAN
#define EN_SCAN 1
#endif
#define LAS __attribute__((address_space(3)))
#define DI __device__ __forceinline__
typedef unsigned short bf16_t;
typedef short bf16x8 __attribute__((ext_vector_type(8)));
typedef short s16x4 __attribute__((ext_vector_type(4)));
typedef float f32x4 __attribute__((ext_vector_type(4)));
typedef float f32x16 __attribute__((ext_vector_type(16)));
typedef unsigned u32x4 __attribute__((ext_vector_type(4)));
typedef unsigned u32x2 __attribute__((ext_vector_type(2)));

constexpr int TH = 16384;
constexpr int SEQ = 2048;
constexpr int DM = 1024;
constexpr int LDS_BYTES = 147456;
constexpr float EPS = 1e-6f;
constexpr float LOG2_1E4 = 13.287712379549449f;
constexpr float LOG2E = 1.4426950408889634f;
constexpr size_t MiB = (size_t)1 << 20;

constexpr size_t W_RET = 0;
constexpr size_t W_MLA = 32 * MiB;
constexpr size_t W_MLA_SZ = 12 * MiB + MiB / 2;
constexpr size_t O_HB = 57 * MiB;
constexpr size_t O_SSQH = 89 * MiB;
constexpr size_t O_G = 90 * MiB;
constexpr size_t O_RQ = 154 * MiB;
constexpr size_t O_RK = 186 * MiB;
constexpr size_t O_RKDT = 218 * MiB;
constexpr size_t O_RVT = 250 * MiB;
constexpr size_t O_SSQO = 314 * MiB;
constexpr size_t O_LAT = 154 * MiB;
constexpr size_t O_KROPE = 166 * MiB;
constexpr size_t O_SSQQ = 168 * MiB;
constexpr size_t O_SSQKV = 168 * MiB + MiB / 4;
constexpr size_t O_MQ = 169 * MiB;
constexpr size_t O_KN = 265 * MiB;
constexpr size_t O_MVT = 329 * MiB;
constexpr size_t WS_NEED = 393 * MiB;
constexpr size_t O_SSQH2 = 395 * MiB;
constexpr size_t O_BAR = 396 * MiB;
constexpr size_t O_DUMMY = 400 * MiB;

struct Params {
    const float* x; const int* pos;
    const float* lnorm[4];
    const float* ret_win[2]; const float* ret_gn[2]; const float* ret_wout[2];
    const float* mla_win[2]; const float* mla_qn[2]; const float* mla_wqb[2]; const float* mla_kvn[2]; const float* mla_wkvb[2]; const float* mla_wout[2];
    const float* fnorm;
    float* out; unsigned char* ws;
    int ph_lo, ph_hi;
};

DI unsigned pk2(float lo, float hi) {
    typedef __bf16 bf2 __attribute__((ext_vector_type(2)));
    typedef float f2 __attribute__((ext_vector_type(2)));
    f2 v = {lo, hi};
    bf2 b = __builtin_convertvector(v, bf2);
    return __builtin_bit_cast(unsigned, b);
}
DI float bflo(unsigned u) { return __uint_as_float(u << 16); }
DI float bfhi(unsigned u) { return __uint_as_float(u & 0xffff0000u); }
DI float fexp2(float x) { return __builtin_amdgcn_exp2f(x); }
DI void sincos_rev(float ang, float& s, float& c) {
    float rev = ang * 0.15915494309189535f;
    rev = __builtin_amdgcn_fractf(rev);
    s = __builtin_amdgcn_sinf(rev);
    c = __builtin_amdgcn_cosf(rev);
}
DI float silu(float x) { return x * __builtin_amdgcn_rcpf(1.0f + fexp2(-x * LOG2E)); }
DI float rstd_parts(const float* p, int nparts4, float invn) {
    float s = 0.f;
    for (int i = 0; i < nparts4; ++i) { f32x4 v = *(const f32x4*)(p + 4 * i); s += (v.x + v.y) + (v.z + v.w); }
    return __builtin_amdgcn_rsqf(s * invn + EPS);
}
DI u32x4 pack8(const f32x4& a, const f32x4& b, float sc) {
    u32x4 w; w.x = pk2(a[0] * sc, a[1] * sc); w.y = pk2(a[2] * sc, a[3] * sc); w.z = pk2(b[0] * sc, b[1] * sc); w.w = pk2(b[2] * sc, b[3] * sc); return w;
}
#define MFMA32(a, b, c) __builtin_amdgcn_mfma_f32_32x32x16_bf16((a), (b), (c), 0, 0, 0)
DI bf16x8 pack_step(const f32x16& x, int s) {
    u32x4 p;
    p.x = pk2(x[8 * s + 0], x[8 * s + 1]); p.y = pk2(x[8 * s + 2], x[8 * s + 3]); p.z = pk2(x[8 * s + 4], x[8 * s + 5]); p.w = pk2(x[8 * s + 6], x[8 * s + 7]);
    return __builtin_bit_cast(bf16x8, p);
}

namespace pg8 {
constexpr int BM = 256, BK = 64, HALF = 128, HTB = HALF * BK * 2, NXCD = 8, WGM = 8;
DI int lds_byte(int r, int c) { const int st = (r >> 4) * 2 + (c >> 5), rr = r & 15, cc = c & 31, ob = rr * 64 + cc * 2; return st * 1024 + (ob ^ (((ob >> 9) & 1) << 5)); }
DI void stage_rc(int b, int& R, int& C) { const int st = b / 1024, sb = b % 1024, swz = sb ^ (((sb >> 9) & 1) << 5); R = (st >> 1) * 16 + swz / 64; C = (st & 1) * 32 + (swz % 64) / 2; }
DI int perm32(int rho) { const int n = rho >> 4, i = rho & 15; return 8 * (i >> 2) + 4 * n + (i & 3); }
struct Unit { int pm, pn; };
struct StaticOrder {
    int nM, nN, nwg, G, c;
    DI void init(int nM_, int nN_, int G_, int c_) { nM = nM_; nN = nN_; nwg = nM * nN; G = G_; c = c_; }
    DI bool next(int i, Unit& u) const {
        const long L = (long)i * G + c; if (L >= nwg) return false;
        int wgid = (int)L; { const int q = nwg / NXCD, r = nwg % NXCD, xcd = wgid % NXCD, off = wgid / NXCD; wgid = (xcd < r ? xcd * (q + 1) : r * (q + 1) + (xcd - r) * q) + off; }
        const int nig = WGM * nN, gid = wgid / nig, fm = gid * WGM, gsz = (nM - fm) < WGM ? (nM - fm) : WGM;
        u.pm = fm + ((wgid % nig) % gsz); u.pn = (wgid % nig) / gsz; return true;
    }
};
}

enum { E_RETQG = 0, E_RETT, E_OUT, E_MLAIN, E_QB, E_KB, E_VB };
struct GemmD {
    const bf16_t* A; const bf16_t* Bt; int lda, ldb, K, nM, nN, bskip_from, bskip_add, epi;
    const int* pos;
    const float* ssq_in;
    float* ssq_out; float* ssq_out2;
    bf16_t* o0; bf16_t* o1; bf16_t* o2;
    const float* hin; float* hout;
    float lg2a, lg2b, lg2c, lg2d;
    const float* kscale;
};

typedef f32x4 AccT[2][2][4][2];

DI void rope_pair8(const f32x4& a0, const f32x4& a1, const f32x4& b0, const f32x4& b1, float rs, float posf, int i0, float fexp, float osc, u32x4& lo, u32x4& hi) {
#pragma unroll
    for (int e2 = 0; e2 < 4; ++e2) {
        float o0[2], o1[2];
#pragma unroll
        for (int t = 0; t < 2; ++t) {
            const int e = 2 * e2 + t;
            const float v0 = (e < 4 ? a0[e & 3] : a1[e & 3]) * rs, v1 = (e < 4 ? b0[e & 3] : b1[e & 3]) * rs;
            const float invf = fexp2(-(float)(i0 + e) * fexp);
            float sn, cs; sincos_rev(posf * invf, sn, cs);
            o0[t] = (v0 * cs - v1 * sn) * osc; o1[t] = (v1 * cs + v0 * sn) * osc;
        }
        lo[e2] = pk2(o0[0], o0[1]); hi[e2] = pk2(o1[0], o1[1]);
        if (e2 & 1) __builtin_amdgcn_sched_barrier(0);
    }
}

DI void row_stats(const GemmD& g, int pm, int wr, int fr, int fq, bool p16, float invn, float (&rsr)[2][4], int (&posr)[2][4]) {
    f32x4 pv[2][4];
#pragma unroll
    for (int ai = 0; ai < 2; ++ai)
#pragma unroll
        for (int m = 0; m < 4; ++m) {
            const int row = pm * 256 + ai * 128 + wr * 64 + m * 16 + fr;
            pv[ai][m] = p16 ? *(const f32x4*)(g.ssq_in + (size_t)row * 16 + 4 * fq) : *(const f32x4*)(g.ssq_in + (size_t)row * 4);
            posr[ai][m] = g.pos[row];
        }
#pragma unroll
    for (int ai = 0; ai < 2; ++ai)
#pragma unroll
        for (int m = 0; m < 4; ++m) {
            float sm = (pv[ai][m].x + pv[ai][m].y) + (pv[ai][m].z + pv[ai][m].w);
            if (p16) { sm += __shfl_xor(sm, 16); sm += __shfl_xor(sm, 32); }
            rsr[ai][m] = __builtin_amdgcn_rsqf(sm * invn + EPS);
        }
}

DI void gemm_epilogue(const GemmD& g, const AccT& acc, const pg8::Unit& u, int wr, int wc, int fr_, int fq_) {
    const int pm = u.pm, pn = u.pn;
    int fr = fr_, fq = fq_;
    asm volatile("" : "+v"(fr), "+v"(fq));
    const int cw = 32 * wc + 8 * fq;
    float rsr[2][4]; int posr[2][4];
    if (((EPI_MASK >> E_RETQG) & 1) && g.epi == E_RETQG) {
        row_stats(g, pm, wr, fr, fq, true, 1.0f / 1024.0f, rsr, posr);
#pragma unroll
        for (int ai = 0; ai < 2; ++ai)
#pragma unroll
            for (int m = 0; m < 4; ++m) {
                const int row = pm * 256 + ai * 128 + wr * 64 + m * 16 + fr;
                const float rs = rsr[ai][m];
                if (pn < 8) {
                    const int head = pn & 3; const bool isk = pn >= 4;
                    bf16_t* dst = isk ? g.o1 + (size_t)row * 1024 + head * 256 + cw
                                      : g.o0 + ((((size_t)(row >> 5) * 4 + head) * 16 + (cw >> 4)) * 512 + (((cw >> 3) & 1) * 32 + (row & 31)) * 8);
                    const int dst_hi = isk ? 128 : 8 * 512;
                    u32x4 lo, hi;
                    rope_pair8(acc[ai][0][m][0], acc[ai][0][m][1], acc[ai][1][m][0], acc[ai][1][m][1], rs, (float)posr[ai][m], cw, LOG2_1E4 / 128.0f, isk ? 0.0625f : 1.0f, lo, hi);
                    *(u32x4*)dst = lo; *(u32x4*)(dst + dst_hi) = hi;
                } else {
                    bf16_t* dst = g.o2 + (size_t)row * 2048 + (pn - 8) * 256 + cw;
#pragma unroll
                    for (int bj = 0; bj < 2; ++bj) *(u32x4*)(dst + bj * 128) = pack8(acc[ai][bj][m][0], acc[ai][bj][m][1], rs);
                }
            }
    } else if (((EPI_MASK >> E_RETT) & 1) && g.epi == E_RETT) {
        const float lg2 = pm == 0 ? g.lg2a : pm == 1 ? g.lg2b : pm == 2 ? g.lg2c : g.lg2d;
#pragma unroll
        for (int bj = 0; bj < 2; ++bj) {
            const int tok0 = pn * 256 + bj * 128 + cw;
            float rs[8], pf[8];
#pragma unroll
            for (int e = 0; e < 8; ++e) { rs[e] = g.ssq_in[(size_t)(tok0 + e) * 16 + fr]; pf[e] = (float)g.pos[tok0 + e]; }
#pragma unroll
            for (int e = 0; e < 8; ++e) {
                float sm = rs[e];
                sm += __shfl_xor(sm, 1); sm += __shfl_xor(sm, 2); sm += __shfl_xor(sm, 4); sm += __shfl_xor(sm, 8);
                rs[e] = __builtin_amdgcn_rsqf(sm * (1.0f / 1024.0f) + EPS) * fexp2((float)(127 - ((tok0 + e) & 127)) * lg2) * 0.0625f;
            }
#pragma unroll
            for (int m = 0; m < 4; ++m) {
                const int i = wr * 64 + m * 16 + fr;
                const float invf = fexp2(-(float)i * (LOG2_1E4 / 128.0f));
                u32x4 lo, hi;
#pragma unroll
                for (int e2 = 0; e2 < 4; ++e2) {
                    float o0[2], o1[2];
#pragma unroll
                    for (int t = 0; t < 2; ++t) {
                        const int e = 2 * e2 + t;
                        const float v0 = acc[0][bj][m][e >> 2][e & 3] * rs[e], v1 = acc[1][bj][m][e >> 2][e & 3] * rs[e];
                        float sn, cs; sincos_rev(pf[e] * invf, sn, cs);
                        o0[t] = v0 * cs - v1 * sn; o1[t] = v1 * cs + v0 * sn;
                    }
                    lo[e2] = pk2(o0[0], o0[1]); hi[e2] = pk2(o1[0], o1[1]);
                    __builtin_amdgcn_sched_barrier(0);
                }
                *(u32x4*)(g.o0 + (size_t)(pm * 256 + i) * TH + tok0) = lo;
                *(u32x4*)(g.o0 + (size_t)(pm * 256 + 128 + i) * TH + tok0) = hi;
            }
        }
    } else if (((EPI_MASK >> E_VB) & 1) && g.epi == E_VB) {
        const bool hstat = g.lg2a > 0.f;
#pragma unroll
        for (int bj = 0; bj < 2; ++bj) {
            const int tok0 = pn * 256 + bj * 128 + cw;
            float rs[8];
#pragma unroll
            for (int e = 0; e < 8; ++e) rs[e] = hstat ? g.ssq_in[(size_t)(tok0 + e) * 16 + fr] : g.ssq_in[(size_t)(tok0 + e) * 4 + (fr & 3)];
#pragma unroll
            for (int e = 0; e < 8; ++e) {
                float sm = rs[e];
                sm += __shfl_xor(sm, 1); sm += __shfl_xor(sm, 2);
                if (hstat) { sm += __shfl_xor(sm, 4); sm += __shfl_xor(sm, 8); }
                rs[e] = __builtin_amdgcn_rsqf(sm * (hstat ? 1.0f / 1024.0f : 1.0f / 128.0f) + EPS);
            }
#pragma unroll
            for (int ai = 0; ai < 2; ++ai)
#pragma unroll
                for (int m = 0; m < 4; ++m) {
                    const int frow = pm * 256 + ai * 128 + wr * 64 + m * 16 + fr;
                    const f32x4 a = acc[ai][bj][m][0], b = acc[ai][bj][m][1];
                    u32x4 w; w.x = pk2(a[0] * rs[0], a[1] * rs[1]); w.y = pk2(a[2] * rs[2], a[3] * rs[3]);
                    w.z = pk2(b[0] * rs[4], b[1] * rs[5]); w.w = pk2(b[2] * rs[6], b[3] * rs[7]);
                    *(u32x4*)(g.o1 + (size_t)frow * TH + tok0) = w;
                }
        }
    } else if (((EPI_MASK >> E_OUT) & 1) && g.epi == E_OUT) {
#pragma unroll
        for (int ai = 0; ai < 2; ++ai)
#pragma unroll
            for (int mp = 0; mp < 2; ++mp) {
                f32x4 hv[2][2][2];
#pragma unroll
                for (int mm = 0; mm < 2; ++mm)
#pragma unroll
                    for (int bj = 0; bj < 2; ++bj) {
                        const size_t off = (size_t)(pm * 256 + ai * 128 + wr * 64 + (2 * mp + mm) * 16 + fr) * 1024 + pn * 256 + bj * 128 + cw;
                        hv[mm][bj][0] = *(const f32x4*)(g.hin + off); hv[mm][bj][1] = *(const f32x4*)(g.hin + off + 4);
                    }
#pragma unroll
                for (int mm = 0; mm < 2; ++mm) {
                    const int m = 2 * mp + mm;
                    const int row = pm * 256 + ai * 128 + wr * 64 + m * 16 + fr;
                    float ss = 0.f;
#pragma unroll
                    for (int bj = 0; bj < 2; ++bj) {
                        const size_t off = (size_t)row * 1024 + pn * 256 + bj * 128 + cw;
                        const f32x4 h0 = hv[mm][bj][0] + acc[ai][bj][m][0], h1 = hv[mm][bj][1] + acc[ai][bj][m][1];
                        *(f32x4*)(g.hout + off) = h0; *(f32x4*)(g.hout + off + 4) = h1;
                        if (g.o0) *(u32x4*)(g.o0 + off) = pack8(h0, h1, 1.0f);
                        ss += (h0.x * h0.x + h0.y * h0.y) + (h0.z * h0.z + h0.w * h0.w) + (h1.x * h1.x + h1.y * h1.y) + (h1.z * h1.z + h1.w * h1.w);
                    }
                    ss += __shfl_xor(ss, 16); ss += __shfl_xor(ss, 32);
                    if (fq == 0) g.ssq_out[(size_t)row * 16 + pn * 4 + wc] = ss;
                }
            }
    } else if (((EPI_MASK >> E_MLAIN) & 1) && g.epi == E_MLAIN) {
        row_stats(g, pm, wr, fr, fq, true, 1.0f / 1024.0f, rsr, posr);
#pragma unroll
        for (int ai = 0; ai < 2; ++ai)
#pragma unroll
            for (int m = 0; m < 4; ++m) {
                const int row = pm * 256 + ai * 128 + wr * 64 + m * 16 + fr;
                const float rs = rsr[ai][m];
                if (pn == 0) {
                    float ss = 0.f;
#pragma unroll
                    for (int bj = 0; bj < 2; ++bj) {
                        const f32x4 a = acc[ai][bj][m][0] * rs, b = acc[ai][bj][m][1] * rs;
                        *(u32x4*)(g.o0 + (size_t)row * 384 + bj * 128 + cw) = pack8(a, b, 1.0f);
                        ss += (a.x * a.x + a.y * a.y) + (a.z * a.z + a.w * a.w) + (b.x * b.x + b.y * b.y) + (b.z * b.z + b.w * b.w);
                    }
                    ss += __shfl_xor(ss, 16); ss += __shfl_xor(ss, 32);
                    if (fq == 0) g.ssq_out[(size_t)row * 4 + wc] = ss;
                } else if (pn == 1) {
                    float ss = 0.f;
                    if (wc == 0) {
                        u32x4 lo, hi;
                        rope_pair8(acc[ai][0][m][0], acc[ai][0][m][1], acc[ai][1][m][0], acc[ai][1][m][1], rs, (float)posr[ai][m], 8 * fq, LOG2_1E4 / 32.0f, 1.0f, lo, hi);
                        *(u32x4*)(g.o1 + (size_t)row * 64 + 8 * fq) = lo; *(u32x4*)(g.o1 + (size_t)row * 64 + 32 + 8 * fq) = hi;
                    } else {
                        {
                            const f32x4 a = acc[ai][0][m][0] * rs, b = acc[ai][0][m][1] * rs;
                            *(u32x4*)(g.o0 + (size_t)row * 384 + 256 + cw - 32) = pack8(a, b, 1.0f);
                            ss += (a.x * a.x + a.y * a.y) + (a.z * a.z + a.w * a.w) + (b.x * b.x + b.y * b.y) + (b.z * b.z + b.w * b.w);
                        }
                        if (wc == 1) {
                            const f32x4 a = acc[ai][1][m][0] * rs, b = acc[ai][1][m][1] * rs;
                            *(u32x4*)(g.o0 + (size_t)row * 384 + 256 + 96 + 8 * fq) = pack8(a, b, 1.0f);
                            ss += (a.x * a.x + a.y * a.y) + (a.z * a.z + a.w * a.w) + (b.x * b.x + b.y * b.y) + (b.z * b.z + b.w * b.w);
                        }
                    }
                    ss += __shfl_xor(ss, 16); ss += __shfl_xor(ss, 32);
                    if (fq == 0) g.ssq_out2[(size_t)row * 4 + wc] = ss;
                } else {
                    bf16_t* dst = g.o2 + (size_t)row * 2048 + (pn - 2) * 256 + cw;
#pragma unroll
                    for (int bj = 0; bj < 2; ++bj) *(u32x4*)(dst + bj * 128) = pack8(acc[ai][bj][m][0], acc[ai][bj][m][1], rs);
                }
            }
    } else if (((EPI_MASK >> E_QB) & 1) && g.epi == E_QB) {
        row_stats(g, pm, wr, fr, fq, false, 1.0f / 256.0f, rsr, posr);
        const float qscale = 0.07216878364870322f * LOG2E;
#pragma unroll
        for (int ai = 0; ai < 2; ++ai)
#pragma unroll
            for (int m = 0; m < 4; ++m) {
                const int row = pm * 256 + ai * 128 + wr * 64 + m * 16 + fr;
                const float rs = rsr[ai][m] * qscale;
                if (pn < 8) {
#pragma unroll
                    for (int bj = 0; bj < 2; ++bj)
                        *(u32x4*)(g.o0 + ((size_t)row * 16 + 2 * pn + bj) * 192 + cw) = pack8(acc[ai][bj][m][0], acc[ai][bj][m][1], rs);
                } else {
                    const int head = 4 * (pn - 8) + wc;
                    u32x4 lo, hi;
                    rope_pair8(acc[ai][0][m][0], acc[ai][0][m][1], acc[ai][1][m][0], acc[ai][1][m][1], rs, (float)posr[ai][m], 8 * fq, LOG2_1E4 / 32.0f, 1.0f, lo, hi);
                    bf16_t* dst = g.o0 + ((size_t)row * 16 + head) * 192 + 128 + 8 * fq;
                    *(u32x4*)dst = lo; *(u32x4*)(dst + 32) = hi;
                }
            }
    } else if (((EPI_MASK >> E_KB) & 1) && g.epi == E_KB) {
        row_stats(g, pm, wr, fr, fq, false, 1.0f / 128.0f, rsr, posr);
#pragma unroll
        for (int ai = 0; ai < 2; ++ai)
#pragma unroll
            for (int m = 0; m < 4; ++m) {
                const int row = pm * 256 + ai * 128 + wr * 64 + m * 16 + fr;
                const float rs = rsr[ai][m];
#pragma unroll
                for (int bj = 0; bj < 2; ++bj)
                    *(u32x4*)(g.o0 + ((size_t)row * 16 + 2 * pn + bj) * 128 + cw) = pack8(acc[ai][bj][m][0], acc[ai][bj][m][1], rs);
            }
    }
}

DI void gemm_phase(LAS unsigned char* lds, const GemmD& g, int tid0) {
    using namespace pg8;
    const int tid = tid0, wid = __builtin_amdgcn_readfirstlane(tid >> 6), lane = tid & 63, wr = wid >> 2, wc = wid & 3, fr = lane & 15, fq = lane >> 4;
    const int K = g.K, nt = K / BK;
    StaticOrder S; S.init(g.nM, g.nN, (int)gridDim.x, (int)blockIdx.x);
    unsigned voffA, voffB;
    { int R, C; stage_rc(tid * 16, R, C); const int Rb = (R & ~31) + perm32(R & 31);
      voffA = (unsigned)(R * g.lda + C) * 2u; voffB = (unsigned)(Rb * g.ldb + C) * 2u; }
    const size_t pvoffA = (size_t)64 * g.lda * 2, pvoffB = (size_t)64 * g.ldb * 2;
    const size_t kstep = (size_t)(BK * 2);
    const size_t hstepA = (size_t)HALF * g.lda * 2, hstepB = (size_t)HALF * g.ldb * 2;
    const size_t tstepA = 2 * hstepA, tstepB = 2 * hstepB;
    const unsigned ldsw = (unsigned)wid * 1024u;
    const int aoff = lds_byte(wr * 64 + fr, fq * 8), boff = lds_byte(wc * 32 + fr, fq * 8);
#define PG8_SA(b, h) (((b) * 2 + (h)) * HTB)
#define PG8_SB(b, h) ((4 + (b) * 2 + (h)) * HTB)
#define PG8_STAGE(bufoff, gbase, voff) do { _Pragma("unroll") for (int _i = 0; _i < 2; ++_i) \
        __builtin_amdgcn_global_load_lds((const unsigned*)((const char*)(gbase) + _i * p##voff + voff), (LAS unsigned*)(lds + (bufoff) + ldsw + _i * 8192), 16, 0, 0); } while (0)
#define PG8_LDA(dst, b, h) do { _Pragma("unroll") for (int m = 0; m < 4; ++m) _Pragma("unroll") for (int k = 0; k < 2; ++k) dst[m][k] = *(const LAS bf16x8*)(lds + PG8_SA(b, h) + aoff + m * 2048 + k * 1024); } while (0)
#define PG8_LDB(dst, b, h) do { _Pragma("unroll") for (int n = 0; n < 2; ++n) _Pragma("unroll") for (int k = 0; k < 2; ++k) dst[n][k] = *(const LAS bf16x8*)(lds + PG8_SB(b, h) + boff + n * 2048 + k * 1024); } while (0)
#define PG8_MMA(ai, bj, At, Bt) do { __builtin_amdgcn_s_setprio(1); _Pragma("unroll") for (int m = 0; m < 4; ++m) _Pragma("unroll") for (int n = 0; n < 2; ++n) _Pragma("unroll") for (int k = 0; k < 2; ++k) \
        acc[ai][bj][m][n] = __builtin_amdgcn_mfma_f32_16x16x32_bf16(Bt[n][k], At[m][k], acc[ai][bj][m][n], 0, 0, 0); __builtin_amdgcn_s_setprio(0); } while (0)
#define PG8_WAIT_V(n) asm volatile("s_waitcnt vmcnt(" #n ")" ::: "memory")
#define PG8_WAIT_L(n) asm volatile("s_waitcnt lgkmcnt(" #n ")" ::: "memory")
#define PG8_BAR __builtin_amdgcn_s_barrier()
#define PG8_SCHED __builtin_amdgcn_sched_barrier(0)
#define PG8_BTILE(pn) ((pn) + ((pn) >= g.bskip_from ? g.bskip_add : 0))
    Unit cur, nxt; int ui = 0;
    if (!S.next(0, cur)) return;
    LAS float* ktab = (LAS float*)(lds + 131072 + wid * 2048);
#define PG8_KTAB(u_) do { if (g.kscale) { \
        _Pragma("unroll 1") for (int rr_ = 0; rr_ < 2; ++rr_) { const int rl_ = lane + 64 * rr_; \
            const int grow_ = (u_).pm * 256 + (rl_ >> 6) * 128 + wr * 64 + (rl_ & 63); float rprev_ = 0.f; \
            _Pragma("unroll 2") for (int h_ = 0; h_ < 4; ++h_) { const float* p_ = g.kscale + ((size_t)grow_ * 4 + h_) * 16; \
                const f32x4 a_ = *(const f32x4*)p_, b_ = *(const f32x4*)(p_ + 4), c_ = *(const f32x4*)(p_ + 8), d_ = *(const f32x4*)(p_ + 12); \
                const float sm_ = ((a_.x + a_.y) + (a_.z + a_.w)) + ((b_.x + b_.y) + (b_.z + b_.w)) + ((c_.x + c_.y) + (c_.z + c_.w)) + ((d_.x + d_.y) + (d_.z + d_.w)); \
                const float rc_ = __builtin_amdgcn_rsqf(sm_ * (1.0f / 512.0f) + EPS); \
                if (h_ > 0) ktab[(h_ - 1) * 128 + rl_] = rprev_ / rc_; \
                rprev_ = rc_; } \
            ktab[3 * 128 + rl_] = rprev_; } \
        asm volatile("s_waitcnt lgkmcnt(0)" ::: "memory"); } } while (0)
    PG8_KTAB(cur);
    AccT acc;
    float zz = 0.f; asm volatile("" : "+v"(zz));
#pragma unroll
    for (int a = 0; a < 2; ++a)
#pragma unroll
        for (int b = 0; b < 2; ++b)
#pragma unroll
            for (int m = 0; m < 4; ++m)
#pragma unroll
                for (int n = 0; n < 2; ++n) acc[a][b][m][n] = (f32x4){zz, zz, zz, zz};
    bf16x8 At[4][2], B0[2][2], B1[2][2];
    const char* cA = (const char*)g.A + (size_t)cur.pm * tstepA; const char* cB = (const char*)g.Bt + (size_t)PG8_BTILE(cur.pn) * tstepB;
    PG8_STAGE(PG8_SB(0, 0), cB, voffB); PG8_STAGE(PG8_SA(0, 0), cA, voffA); PG8_STAGE(PG8_SB(0, 1), cB + hstepB, voffB); PG8_STAGE(PG8_SA(0, 1), cA + hstepA, voffA);
    if (wr == 1) PG8_BAR;
    PG8_WAIT_V(4); PG8_BAR;
    PG8_STAGE(PG8_SB(1, 0), cB + kstep, voffB); PG8_STAGE(PG8_SA(1, 0), cA + kstep, voffA); PG8_STAGE(PG8_SB(1, 1), cB + hstepB + kstep, voffB);
    PG8_WAIT_V(6); PG8_BAR;
    for (;;) {
        const bool has_next = S.next(ui + 1, nxt);
        const char* nA = has_next ? (const char*)g.A + (size_t)nxt.pm * tstepA : cA; const char* nB = has_next ? (const char*)g.Bt + (size_t)PG8_BTILE(nxt.pn) * tstepB : cB;
        const int seglen = g.kscale ? 8 : nt;
        for (int t0 = 0; t0 < nt; t0 += seglen) {
        if (g.kscale && t0 > 0) {
            float rt[2][4];
#pragma unroll
            for (int a = 0; a < 2; ++a)
#pragma unroll
                for (int m = 0; m < 4; ++m) rt[a][m] = ktab[((t0 >> 3) - 1) * 128 + a * 64 + m * 16 + fr];
            asm volatile("s_waitcnt lgkmcnt(0)" ::: "memory");
#pragma unroll
            for (int a = 0; a < 2; ++a)
#pragma unroll
                for (int b = 0; b < 2; ++b)
#pragma unroll
                    for (int m = 0; m < 4; ++m)
#pragma unroll
                        for (int n = 0; n < 2; ++n) acc[a][b][m][n] *= rt[a][m];
        }
        for (int t = t0; t < t0 + seglen; t += 2) {
            const bool last = (t == nt - 2);
            const char* a1 = cA + (size_t)(t + 1) * kstep;
            const char* a2 = last ? nA : cA + (size_t)(t + 2) * kstep; const char* b2 = last ? nB : cB + (size_t)(t + 2) * kstep;
            const char* a3 = a2 + kstep; const char* b3 = b2 + kstep;
            PG8_LDB(B0, 0, 0); PG8_SCHED; PG8_LDA(At, 0, 0); PG8_STAGE(PG8_SA(1, 1), a1 + hstepA, voffA);
            PG8_WAIT_L(8); PG8_BAR; PG8_WAIT_L(0); PG8_MMA(0, 0, At, B0); PG8_BAR; PG8_SCHED;
            PG8_LDB(B1, 0, 1); PG8_STAGE(PG8_SB(0, 0), b2, voffB);
            PG8_BAR; PG8_WAIT_L(0); PG8_MMA(0, 1, At, B1); PG8_BAR;
            PG8_LDA(At, 0, 1); PG8_STAGE(PG8_SA(0, 0), a2, voffA);
            PG8_BAR; PG8_WAIT_L(0); PG8_MMA(1, 0, At, B0); PG8_BAR; PG8_SCHED;
            PG8_STAGE(PG8_SB(0, 1), b2 + hstepB, voffB);
            PG8_WAIT_V(6); PG8_BAR; PG8_MMA(1, 1, At, B1); PG8_BAR;
            PG8_LDB(B0, 1, 0); PG8_SCHED; PG8_LDA(At, 1, 0); PG8_STAGE(PG8_SA(0, 1), a2 + hstepA, voffA);
            PG8_WAIT_L(8); PG8_BAR; PG8_WAIT_L(0); PG8_MMA(0, 0, At, B0); PG8_BAR; PG8_SCHED;
            PG8_LDB(B1, 1, 1); PG8_STAGE(PG8_SB(1, 0), b3, voffB);
            PG8_BAR; PG8_WAIT_L(0); PG8_MMA(0, 1, At, B1); PG8_BAR;
            PG8_LDA(At, 1, 1); PG8_STAGE(PG8_SA(1, 0), a3, voffA);
            PG8_BAR; PG8_WAIT_L(0); PG8_MMA(1, 0, At, B0); PG8_BAR; PG8_SCHED;
            PG8_STAGE(PG8_SB(1, 1), b3 + hstepB, voffB);
            PG8_WAIT_V(6); PG8_BAR; PG8_MMA(1, 1, At, B1); PG8_BAR;
        }
        }
        if (g.kscale) {
            float rt[2][4];
#pragma unroll
            for (int a = 0; a < 2; ++a)
#pragma unroll
                for (int m = 0; m < 4; ++m) rt[a][m] = ktab[3 * 128 + a * 64 + m * 16 + fr];
            asm volatile("s_waitcnt lgkmcnt(0)" ::: "memory");
#pragma unroll
            for (int a = 0; a < 2; ++a)
#pragma unroll
                for (int b = 0; b < 2; ++b)
#pragma unroll
                    for (int m = 0; m < 4; ++m)
#pragma unroll
                        for (int n = 0; n < 2; ++n) acc[a][b][m][n] *= rt[a][m];
        }
        gemm_epilogue(g, acc, cur, wr, wc, fr, fq);
        if (!has_next) break;
        PG8_KTAB(nxt);
        asm volatile("" : "+v"(zz));
#pragma unroll
        for (int a = 0; a < 2; ++a)
#pragma unroll
            for (int b = 0; b < 2; ++b)
#pragma unroll
                for (int m = 0; m < 4; ++m)
#pragma unroll
                    for (int n = 0; n < 2; ++n) acc[a][b][m][n] = (f32x4){zz, zz, zz, zz};
        cur = nxt; cA = nA; cB = nB; ++ui;
    }
    PG8_WAIT_V(0);
    if (wr == 0) PG8_BAR;
    PG8_BAR;
}

struct WJob { const float* W; const float* gain; bf16_t* dst; int K, Nsrc, Nout, Kout, koff, map; };
DI int src_col(int map, int n) {
    if (map == 0) return n;
    if (map == 1) {
        if (n < 256) return n;
        if (n < 512) { const int c = n - 256;
            if (c < 32) return 384 + c; if (c < 128) return 256 + (c - 32); if (c < 160) return 384 + 32 + (c - 128); if (c < 192) return 256 + 96 + (c - 160); return -1; }
        return 448 + (n - 512);
    }
    if (map == 2) {
        const int pn = n >> 8, c = n & 255;
        if (pn < 8) return (2 * pn + (c >> 7)) * 192 + (c & 127);
        const int cl = c & 127; return (4 * (pn - 8) + (cl >> 5)) * 192 + 128 + (cl & 31) + ((c >> 7) ? 32 : 0);
    }
    if (map == 3) return (n >> 7) * 256 + (n & 127);
    return (n >> 7) * 256 + 128 + (n & 127);
}
DI WJob get_job(const Params& P, int j) {
    WJob w; w.koff = 0; w.map = 0; w.gain = nullptr;
    if (j < 4) { const int l = j >> 1; unsigned char* base = P.ws + W_RET + (size_t)l * 16 * MiB;
        if ((j & 1) == 0) { w.W = P.ret_win[l]; w.gain = P.lnorm[2 * l]; w.dst = (bf16_t*)base; w.K = 1024; w.Nsrc = 6144; w.Nout = 6144; w.Kout = 1024; }
        else { w.W = P.ret_wout[l]; w.gain = P.ret_gn[l]; w.dst = (bf16_t*)(base + 12 * MiB); w.K = 2048; w.Nsrc = 1024; w.Nout = 1024; w.Kout = 2048; }
        return w; }
    const int jj = j - 4, l = jj / 5, k = jj % 5; unsigned char* base = P.ws + W_MLA + (size_t)l * W_MLA_SZ;
    if (k == 0) { w.W = P.mla_win[l]; w.gain = P.lnorm[2 * l + 1]; w.dst = (bf16_t*)base; w.K = 1024; w.Nsrc = 2496; w.Nout = 2560; w.Kout = 1024; w.map = 1; }
    else if (k == 1) { w.W = P.mla_wqb[l]; w.gain = P.mla_qn[l]; w.dst = (bf16_t*)(base + 5 * MiB); w.K = 256; w.Nsrc = 3072; w.Nout = 3072; w.Kout = 256; w.map = 2; }
    else if (k == 2) { w.W = P.mla_wkvb[l]; w.gain = P.mla_kvn[l]; w.dst = (bf16_t*)(base + 6 * MiB + MiB / 2); w.K = 128; w.Nsrc = 4096; w.Nout = 2048; w.Kout = 128; w.koff = 0; w.map = 3; }
    else if (k == 3) { w.W = P.mla_wkvb[l]; w.gain = P.mla_kvn[l]; w.dst = (bf16_t*)(base + 7 * MiB + MiB / 2); w.K = 128; w.Nsrc = 4096; w.Nout = 2048; w.Kout = 128; w.koff = 0; w.map = 4; }
    else { w.W = P.mla_wout[l]; w.dst = (bf16_t*)(base + 8 * MiB + MiB / 2); w.K = 2048; w.Nsrc = 1024; w.Nout = 1024; w.Kout = 2048; }
    return w;
}
DI void wprep_phase(LAS unsigned char* lds, const Params& P, int tid0) {
    const int tid = tid0, wid = tid >> 6, lane = tid & 63;
    LAS float* scr = (LAS float*)(lds + wid * 8704);
    constexpr int NJ = 14;
    constexpr int cnt[NJ] = {3072, 1024, 3072, 1024, 1280, 384, 128, 128, 1024, 1280, 384, 128, 128, 1024};
    constexpr int NTOT = 2 * (3072 + 1024) + 2 * (1280 + 384 + 128 + 128 + 1024);
    for (int it0 = blockIdx.x * 8; it0 < NTOT; it0 += gridDim.x * 8) {
        int it = it0 + wid, j = 0;
        const bool live = it < NTOT;
        if (live) {
#pragma unroll
            for (int q = 0; q < NJ - 1; ++q) if (j == q && it >= cnt[q]) { it -= cnt[q]; j = q + 1; }
        }
        j = __builtin_amdgcn_readfirstlane(j); it = __builtin_amdgcn_readfirstlane(it);
        WJob w = get_job(P, live ? j : 0);
        const int nblk = w.Nout / 32;
        const int kb = it / nblk, nb = it % nblk, k0 = 64 * kb, n0 = 32 * nb;
        if (live) {
            const int sc = src_col(w.map, n0 + (lane & 31));
#pragma unroll 8
            for (int i = 0; i < 32; ++i) {
                const int kk = 2 * i + (lane >> 5), ks = k0 + kk - w.koff;
                float v = 0.f;
                if (sc >= 0 && ks >= 0) { v = w.W[(size_t)ks * w.Nsrc + sc]; if (w.gain) v *= w.gain[ks]; }
                scr[kk * 33 + (lane & 31)] = v;
            }
        }
        __syncthreads();
        if (live) {
            const int c = lane & 7;
#pragma unroll
            for (int jn = 0; jn < 4; ++jn) { const int n = (lane >> 3) + 8 * jn; const LAS float* sp = scr + (8 * c) * 33 + n;
                u32x4 o; o.x = pk2(sp[0 * 33], sp[1 * 33]); o.y = pk2(sp[2 * 33], sp[3 * 33]); o.z = pk2(sp[4 * 33], sp[5 * 33]); o.w = pk2(sp[6 * 33], sp[7 * 33]);
                *(u32x4*)(w.dst + (size_t)(n0 + n) * w.Kout + k0 + 8 * c) = o; }
        }
        __syncthreads();
    }
}

DI void xprep_phase(const Params& P, int half, int tid0) {
    const int wid = tid0 >> 6, lane = tid0 & 63;
    const float* x = P.x + (size_t)half * TH * DM;
    bf16_t* hb = (bf16_t*)(P.ws + O_HB); float* ssq = (float*)(P.ws + (half ? O_SSQH2 : O_SSQH));
    const int rstep = gridDim.x * 8;
    for (int row = blockIdx.x * 8 + wid; row < TH; row += 2 * rstep) {
        const int row2 = row + rstep; const bool has2 = row2 < TH; const int r2 = has2 ? row2 : row;
        const f32x4* xr = (const f32x4*)(x + (size_t)row * DM) + lane; const f32x4* xr2 = (const f32x4*)(x + (size_t)r2 * DM) + lane;
        f32x4 v[4], v2[4];
#pragma unroll
        for (int j = 0; j < 4; ++j) { v[j] = xr[64 * j]; v2[j] = xr2[64 * j]; }
        float s = 0.f, s2 = 0.f;
#pragma unroll
        for (int j = 0; j < 4; ++j) { s += (v[j].x * v[j].x + v[j].y * v[j].y) + (v[j].z * v[j].z + v[j].w * v[j].w);
            s2 += (v2[j].x * v2[j].x + v2[j].y * v2[j].y) + (v2[j].z * v2[j].z + v2[j].w * v2[j].w);
            u32x2 o; o.x = pk2(v[j].x, v[j].y); o.y = pk2(v[j].z, v[j].w); *((u32x2*)(hb + (size_t)row * DM) + lane + 64 * j) = o; }
        if (has2) {
#pragma unroll
            for (int j = 0; j < 4; ++j) { u32x2 o; o.x = pk2(v2[j].x, v2[j].y); o.y = pk2(v2[j].z, v2[j].w); *((u32x2*)(hb + (size_t)r2 * DM) + lane + 64 * j) = o; }
        }
#pragma unroll
        for (int o = 1; o < 64; o <<= 1) { s += __shfl_xor(s, o); s2 += __shfl_xor(s2, o); }
        if (lane < 16) { ssq[(size_t)row * 16 + lane] = lane == 0 ? s : 0.f; if (has2) ssq[(size_t)r2 * 16 + lane] = lane == 0 ? s2 : 0.f; }
    }
}

DI void gnorm_phase(const Params& P, int tid0, bool dry) {
    bf16_t* G = (bf16_t*)(P.ws + O_G); bf16_t* Go = (bf16_t*)(P.ws + (dry ? O_DUMMY : O_G)); const float* ssqo = (const float*)(P.ws + O_SSQO);
    const size_t nvec = (size_t)TH * 2048 / 8;
    for (size_t v = (size_t)blockIdx.x * 512 + tid0; v < nvec; v += (size_t)gridDim.x * 512) {
        const int row = (int)(v >> 8), c = (int)(v & 255) * 8, head = c >> 9;
        const float rs = rstd_parts(ssqo + ((size_t)row * 4 + head) * 16, 4, 1.0f / 512.0f);
        u32x4 w = *(u32x4*)(G + (size_t)row * 2048 + c);
        w.x = pk2(bflo(w.x) * rs, bfhi(w.x) * rs); w.y = pk2(bflo(w.y) * rs, bfhi(w.y) * rs); w.z = pk2(bflo(w.z) * rs, bfhi(w.z) * rs); w.w = pk2(bflo(w.w) * rs, bfhi(w.w) * rs);
        *(u32x4*)(Go + (size_t)row * 2048 + c) = w;
    }
}
DI void final_phase(const Params& P, int half, int tid0, bool dry) {
    float* h = P.out + (size_t)half * TH * DM; float* ho = dry ? (float*)(P.ws + O_DUMMY) : h; const float* ssq = (const float*)(P.ws + O_SSQH);
    const int wid = tid0 >> 6, lane = tid0 & 63;
    f32x4 gn[4];
#pragma unroll
    for (int j = 0; j < 4; ++j) gn[j] = *((const f32x4*)P.fnorm + lane + 64 * j);
    const int rstep = gridDim.x * 8;
    for (int row = blockIdx.x * 8 + wid; row < TH; row += 2 * rstep) {
        const int row2 = row + rstep; const bool has2 = row2 < TH; const int r2 = has2 ? row2 : row;
        float sm = ssq[(size_t)row * 16 + (lane & 15)], sm2 = ssq[(size_t)r2 * 16 + (lane & 15)];
        const f32x4* xr = (const f32x4*)(h + (size_t)row * DM) + lane; const f32x4* xr2 = (const f32x4*)(h + (size_t)r2 * DM) + lane;
        f32x4 v[4], v2[4];
#pragma unroll
        for (int j = 0; j < 4; ++j) { v[j] = xr[64 * j]; v2[j] = xr2[64 * j]; }
        sm += __shfl_xor(sm, 1); sm += __shfl_xor(sm, 2); sm += __shfl_xor(sm, 4); sm += __shfl_xor(sm, 8);
        sm2 += __shfl_xor(sm2, 1); sm2 += __shfl_xor(sm2, 2); sm2 += __shfl_xor(sm2, 4); sm2 += __shfl_xor(sm2, 8);
        const float rs = __builtin_amdgcn_rsqf(sm * (1.0f / 1024.0f) + EPS), rs2 = __builtin_amdgcn_rsqf(sm2 * (1.0f / 1024.0f) + EPS);
        f32x4* yr = (f32x4*)(ho + (size_t)row * DM) + lane; f32x4* yr2 = (f32x4*)(ho + (size_t)r2 * DM) + lane;
#pragma unroll
        for (int j = 0; j < 4; ++j) yr[64 * j] = v[j] * rs * gn[j];
        if (has2) {
#pragma unroll
            for (int j = 0; j < 4; ++j) yr2[64 * j] = v2[j] * rs2 * gn[j];
        }
    }
}

DI void attn_phase(LAS unsigned char* lds, const Params& P, int tid0, bool dry) {
    const size_t gdelta = dry ? (O_DUMMY - O_G) / 2 : 0;
    const bf16_t* MQ = (const bf16_t*)(P.ws + O_MQ); const bf16_t* KN = (const bf16_t*)(P.ws + O_KN);
    const bf16_t* KR = (const bf16_t*)(P.ws + O_KROPE); const bf16_t* MVT = (const bf16_t*)(P.ws + O_MVT); bf16_t* G = (bf16_t*)(P.ws + O_G);
    const int tid = tid0, wid = __builtin_amdgcn_readfirstlane(tid >> 6), lane = tid & 63, r = lane & 31, hh = lane >> 5;
    constexpr int KST = 400, VST = 136, KBUF = 64 * KST, VBUF = 128 * VST, VOFF = 2 * KBUF;
    static_assert(VOFF + 2 * VBUF <= LDS_BYTES, "lds");
    const int nit = (int)blockIdx.x < 512 ? ((511 - (int)blockIdx.x) / (int)gridDim.x + 1) * 2 : 0;
#define ATT_DECODE(it_, B_, H_, QB_) do { const int pi_ = (int)blockIdx.x + ((it_) >> 1) * (int)gridDim.x, pl_ = pi_ & 255, bh_ = (pi_ >> 8) * 64 + (pl_ & 7) * 8 + ((pl_ >> 3) >> 2), jp_ = (pl_ >> 3) & 3; \
        QB_ = ((it_) & 1) ? jp_ : 7 - jp_; B_ = bh_ >> 4; H_ = bh_ & 15; } while (0)
    bf16x8 qf[12];
    u32x4 kreg[3], vreg[2];
    const bf16_t* knsrc; const bf16_t* krsrc; const bf16_t* vtsrc;
    int tv = tid, rr = r, h2 = hh;
    asm volatile("" : "+v"(tv), "+v"(rr), "+v"(h2));
#define ATT_SETPTR(B_, H_) do { const int skey_ = tv >> 3, sc8_ = tv & 7, sdv_ = tv >> 2, sc4_ = tv & 3; \
        knsrc = KN + (((size_t)(B_) * SEQ + skey_) * 16 + (H_)) * 128 + sc8_ * 8; krsrc = KR + ((size_t)(B_) * SEQ + skey_) * 64 + sc8_ * 8; \
        vtsrc = MVT + (size_t)((H_) * 128 + sdv_) * TH + (size_t)(B_) * SEQ + sc4_ * 8; } while (0)
#define ATT_QLOAD(B_, H_, QB_) do { const size_t tq_ = (size_t)(B_) * SEQ + (QB_) * 256 + 32 * wid + rr; \
        _Pragma("unroll") for (int kk = 0; kk < 12; ++kk) qf[kk] = *(const bf16x8*)(MQ + (tq_ * 16 + (H_)) * 192 + 16 * kk + 8 * h2); } while (0)
#define ATT_LOAD(kt) do { \
    kreg[0] = *(const u32x4*)(knsrc + (size_t)(kt) * 64 * 2048); kreg[1] = *(const u32x4*)(knsrc + (size_t)(kt) * 64 * 2048 + 64); \
    kreg[2] = *(const u32x4*)(krsrc + (size_t)(kt) * 64 * 64); \
    vreg[0] = *(const u32x4*)(vtsrc + (kt) * 64); vreg[1] = *(const u32x4*)(vtsrc + (kt) * 64 + 32); } while (0)
    int b = 0, h = 0, qb = 0;
    if (nit > 0) { ATT_DECODE(0, b, h, qb); ATT_SETPTR(b, h); ATT_QLOAD(b, h, qb); ATT_LOAD(0); }
    for (int it = 0; it < nit; ++it) {
        {
            const int nkt = 4 * (qb + 1);
            const int q0w = qb * 256 + 32 * wid;
            tv = tid; rr = r; h2 = hh;
            asm volatile("" : "+v"(tv), "+v"(rr), "+v"(h2));
            const size_t tokq = (size_t)b * SEQ + q0w + rr;
            const int skey = tv >> 3, sc8 = tv & 7, sdv = tv >> 2, sc4 = tv & 3;
            LAS unsigned char* kdst0 = lds + skey * KST;
            LAS unsigned char* vdst0 = lds + VOFF + sdv * VST + sc4 * 16;
#define ATT_STORE(buf) do { LAS unsigned char* kdst = kdst0 + (buf) * KBUF; LAS unsigned char* vdst = vdst0 + (buf) * VBUF; \
    *(LAS u32x4*)(kdst + sc8 * 16) = kreg[0]; *(LAS u32x4*)(kdst + 128 + sc8 * 16) = kreg[1]; *(LAS u32x4*)(kdst + 256 + sc8 * 16) = kreg[2]; \
    *(LAS u32x2*)(vdst) = (u32x2){vreg[0].x, vreg[0].y}; *(LAS u32x2*)(vdst + 8) = (u32x2){vreg[0].z, vreg[0].w}; \
    *(LAS u32x2*)(vdst + 64) = (u32x2){vreg[1].x, vreg[1].y}; *(LAS u32x2*)(vdst + 72) = (u32x2){vreg[1].z, vreg[1].w}; } while (0)
            __syncthreads();
            ATT_STORE(0);
            if (nkt > 1) ATT_LOAD(1);
            __syncthreads();
            f32x16 o[4];
#pragma unroll
            for (int d = 0; d < 4; ++d)
#pragma unroll
                for (int e = 0; e < 16; ++e) o[d][e] = 0.f;
            float mrun = -1e30f, lrun = 0.f;
            for (int kt = 0; kt < nkt; ++kt) {
                const int buf = kt & 1;
                if (64 * kt <= q0w + 31) {
                    f32x16 s[2];
#pragma unroll
                    for (int jt = 0; jt < 2; ++jt)
#pragma unroll
                        for (int e = 0; e < 16; ++e) s[jt][e] = 0.f;
                    {
                        bf16x8 kf[2][4];
                        const LAS unsigned char* kb = lds + buf * KBUF + r * KST + hh * 16;
#define ATT_KREAD(dst, g_) do { _Pragma("unroll") for (int u = 0; u < 4; ++u) dst[u] = *(const LAS bf16x8*)(kb + (32 * (u & 1)) * KST + (2 * (g_) + (u >> 1)) * 32); } while (0)
                        ATT_KREAD(kf[0], 0);
#pragma unroll
                        for (int gq = 0; gq < 6; ++gq) {
                            if (gq < 5) ATT_KREAD(kf[(gq + 1) & 1], gq + 1);
                            __builtin_amdgcn_sched_barrier(0);
                            __builtin_amdgcn_s_setprio(1);
#pragma unroll
                            for (int u = 0; u < 4; ++u) s[u & 1] = MFMA32(kf[gq & 1][u], qf[2 * gq + (u >> 1)], s[u & 1]);
                            __builtin_amdgcn_s_setprio(0);
                            __builtin_amdgcn_sched_barrier(0);
                        }
#undef ATT_KREAD
                    }
                    const bool diag = 64 * kt + 63 > q0w;
                    float mx = -1e30f;
#pragma unroll
                    for (int jt = 0; jt < 2; ++jt)
#pragma unroll
                        for (int e = 0; e < 16; ++e) {
                            if (diag) { const int key = 64 * kt + 32 * jt + (e & 3) + 8 * (e >> 2) + 4 * hh; if (key > q0w + r) s[jt][e] = -1e30f; }
                            mx = fmaxf(mx, s[jt][e]);
                        }
                    mx = fmaxf(mx, __shfl_xor(mx, 32));
                    if (__builtin_amdgcn_ballot_w64(mx > mrun + 8.0f) != 0ull) {
                        const float mnew = fmaxf(mrun, mx), alpha = fexp2(mrun - mnew);
                        mrun = mnew; lrun *= alpha;
#pragma unroll
                        for (int d = 0; d < 4; ++d)
#pragma unroll
                            for (int e = 0; e < 16; ++e) o[d][e] *= alpha;
                    }
                    float ls = 0.f;
#pragma unroll
                    for (int jt = 0; jt < 2; ++jt)
#pragma unroll
                        for (int e = 0; e < 16; ++e) { const float p = fexp2(s[jt][e] - mrun); s[jt][e] = p; ls += p; }
                    lrun += ls;
                    bf16x8 pf[2][2];
#pragma unroll
                    for (int jt = 0; jt < 2; ++jt) { pf[jt][0] = pack_step(s[jt], 0); pf[jt][1] = pack_step(s[jt], 1); }
                    {
                        bf16x8 vf[2][2];
                        const LAS unsigned char* vbp = lds + VOFF + buf * VBUF + r * VST + hh * 8;
#define ATT_VREAD(dst, g_) do { _Pragma("unroll") for (int u = 0; u < 2; ++u) { const LAS unsigned char* vp = vbp + (32 * ((g_) >> 1)) * VST + (2 * ((g_) & 1) + u) * 32; \
        const s16x4 lo = *(const LAS s16x4*)vp, hi = *(const LAS s16x4*)(vp + 16); dst[u] = __builtin_shufflevector(lo, hi, 0, 1, 2, 3, 4, 5, 6, 7); } } while (0)
                        ATT_VREAD(vf[0], 0);
#pragma unroll
                        for (int g8 = 0; g8 < 8; ++g8) {
                            if (g8 < 7) ATT_VREAD(vf[(g8 + 1) & 1], g8 + 1);
                            __builtin_amdgcn_sched_barrier(0);
                            __builtin_amdgcn_s_setprio(1);
#pragma unroll
                            for (int u = 0; u < 2; ++u) o[g8 >> 1] = MFMA32(vf[g8 & 1][u], pf[g8 & 1][u], o[g8 >> 1]);
                            __builtin_amdgcn_s_setprio(0);
                            __builtin_amdgcn_sched_barrier(0);
                        }
#undef ATT_VREAD
                    }
                }
                if (kt + 1 < nkt) ATT_STORE(buf ^ 1);
                if (kt + 2 < nkt) ATT_LOAD(kt + 2);
                __syncthreads();
            }
            int nb = b, nh = h, nqb = qb;
            if (it + 1 < nit) { ATT_DECODE(it + 1, nb, nh, nqb); ATT_SETPTR(nb, nh); ATT_QLOAD(nb, nh, nqb); ATT_LOAD(0); }
            lrun += __shfl_xor(lrun, 32);
            const float inv = 1.0f / lrun;
            u32x2 gt[4][4];
#pragma unroll
            for (int d = 0; d < 4; ++d)
#pragma unroll
                for (int g4 = 0; g4 < 4; ++g4) gt[d][g4] = *(const u32x2*)(G + tokq * 2048 + h * 128 + 32 * d + 8 * g4 + 4 * h2);
#pragma unroll
            for (int d = 0; d < 4; ++d)
#pragma unroll
                for (int g4 = 0; g4 < 4; ++g4) {
                    bf16_t* gp = G + tokq * 2048 + h * 128 + 32 * d + 8 * g4 + 4 * h2;
                    u32x2 w;
                    w.x = pk2(o[d][4 * g4 + 0] * inv * silu(bflo(gt[d][g4].x)), o[d][4 * g4 + 1] * inv * silu(bfhi(gt[d][g4].x)));
                    w.y = pk2(o[d][4 * g4 + 2] * inv * silu(bflo(gt[d][g4].y)), o[d][4 * g4 + 3] * inv * silu(bfhi(gt[d][g4].y)));
                    *(u32x2*)(gp + gdelta) = w;
                }
            b = nb; h = nh; qb = nqb;
        }
    }
#undef ATT_LOAD
#undef ATT_STORE
#undef ATT_DECODE
#undef ATT_SETPTR
#undef ATT_QLOAD
}

DI void scan_phase(LAS unsigned char* lds, const Params& P, int tid0, bool dry) {
    const size_t gdelta = dry ? (O_DUMMY - O_G) / 2 : 0;
    const int skip = dry ? SCAN_SKIP : 0;
    const bf16_t* RQ = (const bf16_t*)(P.ws + O_RQ); const bf16_t* RK = (const bf16_t*)(P.ws + O_RK);
    const bf16_t* VT = (const bf16_t*)(P.ws + O_RVT);
    bf16_t* G = (bf16_t*)(P.ws + O_G); float* SSQO = (float*)(P.ws + O_SSQO);
    const int tid = tid0, wid = __builtin_amdgcn_readfirstlane(tid >> 6), lane = tid & 63, r = lane & 31, hh = lane >> 5;
    constexpr int KS = 528, TS = 272, SLOT = 64 * KS, VTO = 2 * SLOT, VTB = 64 * TS, VDO = VTO + VTB, RST = 528, RIO = VDO + VTB, RIB = 64 * RST;
    static_assert(RIO + RIB <= LDS_BYTES, "lds");
    const int ib = wid < 4 ? wid : 7 - wid, vh = wid >> 2;
    const int dbw = wid & 3, vb = wid >> 2;
    const int trq = (lane & 15) >> 2, trp = lane & 3, trb = (lane >> 4) & 1;
    for (int it = blockIdx.x; it < 256; it += gridDim.x) {
        const int bhx = (it & 7) * 4 + ((it >> 3) >> 3), sl = (it >> 3) & 7, b = bhx >> 2, h = bhx & 3;
        const int v0 = h * 512 + sl * 64;
        const float lg2 = __builtin_log2f(1.0f - fexp2(-5.0f - (float)h));
        const float cdec = fexp2(128.0f * lg2);
        __syncthreads();
        { unsigned zu = 0u; asm volatile("" : "+v"(zu));
          for (int i = tid; i < RIB / 16; i += 512) *(LAS u32x4*)(lds + RIO + i * 16) = (u32x4){zu, zu, zu, zu}; }
        u32x4 stg[4], vstg[2];
#define SC_LOADK(n_, jh_) do { _Pragma("unroll") for (int i = 0; i < 4; ++i) { const int p = tv + 512 * i; \
        stg[i] = *(const u32x4*)(RK + ((size_t)b * SEQ + (n_) * 128 + (jh_) * 64 + (p >> 5)) * 1024 + h * 256 + (p & 31) * 8); } } while (0)
#define SC_STOREK(slot) do { _Pragma("unroll") for (int i = 0; i < 4; ++i) { const int p = tv + 512 * i; \
        *(LAS u32x4*)(lds + (slot) * SLOT + (p >> 5) * KS + (p & 31) * 16) = stg[i]; } } while (0)
#define SC_VLOAD(n_) do { _Pragma("unroll") for (int i = 0; i < 2; ++i) { const int p = tv + 512 * i, row = p >> 4, ch = p & 15; \
        vstg[i] = *(const u32x4*)(VT + (size_t)(v0 + row) * TH + (size_t)b * SEQ + (n_) * 128 + ch * 8); } } while (0)
#define SC_VSTORE() do { _Pragma("unroll") for (int i = 0; i < 2; ++i) { const int p = tv + 512 * i, row = p >> 4, ch = p & 15; \
        *(LAS u32x4*)(lds + VTO + row * TS + ch * 16) = vstg[i]; \
        u32x4 dv_; const float e0_ = (float)(127 - 8 * ch); \
        dv_.x = pk2(bflo(vstg[i].x) * fexp2((e0_ - 0.f) * lg2), bfhi(vstg[i].x) * fexp2((e0_ - 1.f) * lg2)); \
        dv_.y = pk2(bflo(vstg[i].y) * fexp2((e0_ - 2.f) * lg2), bfhi(vstg[i].y) * fexp2((e0_ - 3.f) * lg2)); \
        dv_.z = pk2(bflo(vstg[i].z) * fexp2((e0_ - 4.f) * lg2), bfhi(vstg[i].z) * fexp2((e0_ - 5.f) * lg2)); \
        dv_.w = pk2(bflo(vstg[i].w) * fexp2((e0_ - 6.f) * lg2), bfhi(vstg[i].w) * fexp2((e0_ - 7.f) * lg2)); \
        *(LAS u32x4*)(lds + VDO + row * TS + ch * 16) = dv_; } } while (0)
        int tv = tid, rr = r, h2 = hh;
        asm volatile("" : "+v"(tv), "+v"(rr), "+v"(h2));
        SC_LOADK(0, 0); SC_STOREK(0); SC_VLOAD(0); SC_VSTORE();
        __syncthreads();
        f32x16 X0, X1, oi;
        bf16x8 qa[8], qb[8];
#define SC_QLOAD(dst, n_, kh_) do { _Pragma("unroll") for (int kk = 0; kk < 8; ++kk) \
        dst[kk] = *(const bf16x8*)(RQ + (((((size_t)b * SEQ + (n_) * 128 + 32 * ib) >> 5) * 4 + h) * 16 + 8 * (kh_) + kk) * 512 + (h2 * 32 + rr) * 8); } while (0)
        SC_QLOAD(qa, 0, 0);
#pragma unroll
        for (int e = 0; e < 16; ++e) { X0[e] = 0.f; X1[e] = 0.f; oi[e] = 0.f; }
        for (int gs = 0; gs < 32; ++gs) {
            const int n = gs >> 1, s = gs & 1;
            const size_t tokb = (size_t)b * SEQ + n * 128;
            int iq = 32 * ib + r;
            tv = tid; rr = r; h2 = hh;
            asm volatile("" : "+v"(iq), "+v"(tv), "+v"(rr), "+v"(h2));
            if (s == 0) SC_LOADK(n, 1);
            else if (n < 15) { SC_LOADK(n + 1, 0); SC_VLOAD(n + 1); }
            if (!(skip & 16)) SC_QLOAD(qb, n, 1);
            {
                const bool act = 2 * s <= ib, two = 2 * s + 1 <= ib;
                f32x16 st[2];
#pragma unroll
                for (int jj = 0; jj < 2; ++jj)
#pragma unroll
                    for (int e = 0; e < 16; ++e) st[jj][e] = 0.f;
                if (s == 0) {
#pragma unroll
                    for (int e = 0; e < 16; ++e) oi[e] = 0.f;
                }
                {
                    const LAS unsigned char* kb0 = lds + s * SLOT + r * KS + hh * 16;
                    const LAS unsigned char* rb0 = lds + RIO + (32 * vh + r) * RST + hh * 16;
#define SC_GROUPS(DO1, DOC) do { \
        _Pragma("unroll") for (int g8 = 0; g8 < 8; ++g8) { \
            bf16x8 fk0[2], fk1[2], fr[2]; \
            _Pragma("unroll") for (int u = 0; u < 2; ++u) { \
                fk0[u] = *(const LAS bf16x8*)(kb0 + (2 * g8 + u) * 32); \
                if (DO1) fk1[u] = *(const LAS bf16x8*)(kb0 + 32 * KS + (2 * g8 + u) * 32); \
                if (DOC) fr[u] = *(const LAS bf16x8*)(rb0 + (2 * g8 + u) * 32); } \
            __builtin_amdgcn_sched_barrier(0); \
            _Pragma("unroll") for (int u = 0; u < 2; ++u) { \
                const int ks = 2 * g8 + u; \
                const bf16x8 q = ks < 8 ? qa[ks & 7] : qb[ks & 7]; \
                st[0] = MFMA32(fk0[u], q, st[0]); \
                if (DO1) st[1] = MFMA32(fk1[u], q, st[1]); \
                if (DOC) oi = MFMA32(fr[u], q, oi); }        \
            __builtin_amdgcn_sched_barrier(0); } } while (0)
                    if (!(skip & 1)) {
                        if (s == 0) { if (two) SC_GROUPS(1, 1); else SC_GROUPS(0, 1); }
                        else if (two) SC_GROUPS(1, 0);
                        else if (act) SC_GROUPS(0, 0);
                    }
#undef SC_GROUPS
                }
                if (s == 0) {
                    const float qd = fexp2((float)(iq + 1) * lg2);
#pragma unroll
                    for (int e = 0; e < 16; ++e) oi[e] *= qd;
                }
                if (act) {
#pragma unroll
                    for (int jj = 0; jj < 2; ++jj)
                        if (jj == 0 || two) {
                            const int jt = 2 * s + jj;
#pragma unroll
                            for (int e = 0; e < 16; ++e) { const int j = 32 * jt + (e & 3) + 8 * (e >> 2) + 4 * h2;
                                st[jj][e] = j <= iq ? st[jj][e] * fexp2((float)(iq - j) * lg2) : 0.f; }
#pragma unroll
                            for (int si = 0; si < 2; ++si) {
                                const bf16x8 pf = pack_step(st[jj], si);
                                const LAS unsigned char* vp = lds + VTO + (32 * vh + r) * TS + (32 * jt + 16 * si + 4 * hh) * 2;
                                const s16x4 lo = *(const LAS s16x4*)vp, hi = *(const LAS s16x4*)(vp + 16);
                                const bf16x8 vf = __builtin_shufflevector(lo, hi, 0, 1, 2, 3, 4, 5, 6, 7);
                                oi = MFMA32(vf, pf, oi);
                            }
                        }
                }
            }
            if (s == 0) {
                SC_STOREK(1);
                __syncthreads();
            } else {
                if (!(skip & 8)) {
                    float ss = 0.f;
#pragma unroll
                    for (int e = 0; e < 16; ++e) ss += oi[e] * oi[e];
                    ss += __shfl_xor(ss, 32);
                    const size_t tok = tokb + iq;
                    if (h2 == 0) SSQO[(tok * 4 + h) * 16 + sl * 2 + vh] = ss;
                    u32x2 gts[4];
#pragma unroll
                    for (int g4 = 0; g4 < 4; ++g4) gts[g4] = *(const u32x2*)(G + tok * 2048 + v0 + 32 * vh + 8 * g4 + 4 * h2);
#pragma unroll
                    for (int g4 = 0; g4 < 4; ++g4) {
                        bf16_t* gp = G + tok * 2048 + v0 + 32 * vh + 8 * g4 + 4 * h2;
                        const u32x2 gt = gts[g4];
                        u32x2 w;
                        w.x = pk2(oi[4 * g4 + 0] * silu(bflo(gt.x)), oi[4 * g4 + 1] * silu(bfhi(gt.x)));
                        w.y = pk2(oi[4 * g4 + 2] * silu(bflo(gt.y)), oi[4 * g4 + 3] * silu(bfhi(gt.y)));
                        *(u32x2*)(gp + gdelta) = w;
                    }
                }
                if (n < 15 && !(skip & 4)) {
                    SC_QLOAD(qa, n + 1, 0);
#pragma unroll
                    for (int e = 0; e < 16; ++e) { X0[e] *= cdec; X1[e] *= cdec; }
#pragma unroll
                    for (int kk = 0; kk < 8; ++kk) {
                        const LAS unsigned char* kp = lds + (kk >> 2) * SLOT + (16 * (kk & 3) + 8 * hh + trq) * KS + (32 * dbw + 16 * trb + 4 * trp) * 2;
                        const s16x4 t0 = __builtin_amdgcn_ds_read_tr16_b64_v4i16((LAS s16x4*)kp);
                        const s16x4 t1 = __builtin_amdgcn_ds_read_tr16_b64_v4i16((LAS s16x4*)(kp + 4 * KS));
                        const s16x4 t2 = __builtin_amdgcn_ds_read_tr16_b64_v4i16((LAS s16x4*)(kp + 256));
                        const s16x4 t3 = __builtin_amdgcn_ds_read_tr16_b64_v4i16((LAS s16x4*)(kp + 256 + 4 * KS));
                        const bf16x8 af0 = __builtin_shufflevector(t0, t1, 0, 1, 2, 3, 4, 5, 6, 7), af1 = __builtin_shufflevector(t2, t3, 0, 1, 2, 3, 4, 5, 6, 7);
                        const bf16x8 bf = *(const LAS bf16x8*)(lds + VDO + (32 * vb + r) * TS + (16 * kk + 8 * hh) * 2);
                        X0 = MFMA32(af0, bf, X0);
                        X1 = MFMA32(af1, bf, X1);
                    }
#pragma unroll
                    for (int g4 = 0; g4 < 4; ++g4) {
                        u32x2 w0, w1; w0.x = pk2(X0[4 * g4 + 0], X0[4 * g4 + 1]); w0.y = pk2(X0[4 * g4 + 2], X0[4 * g4 + 3]);
                        w1.x = pk2(X1[4 * g4 + 0], X1[4 * g4 + 1]); w1.y = pk2(X1[4 * g4 + 2], X1[4 * g4 + 3]);
                        *(LAS u32x2*)(lds + RIO + (32 * vb + r) * RST + (32 * dbw + 8 * g4 + 4 * hh) * 2) = w0;
                        *(LAS u32x2*)(lds + RIO + (32 * vb + r) * RST + (128 + 32 * dbw + 8 * g4 + 4 * hh) * 2) = w1;
                    }
                }
                __syncthreads();
                if (n < 15) { SC_STOREK(0); SC_VSTORE(); }
                __syncthreads();
            }
        }
#undef SC_LOADK
#undef SC_STOREK
#undef SC_VLOAD
#undef SC_VSTORE
#undef SC_QLOAD
    }
}

#define XB_TMO      128
#define XB_XCNT(j)  (256  + 64 * (j))
#define XB_XSUB(j)  (1280 + 64 * (j))
#define XB_XGEN(j)  (2304 + 64 * (j))
#define XB_TOP      3328
#define XB_TOPGEN   3392
#define XCD_BAR_WORDS 3456
#define XB_SPIN_CAP (1u << 18)
DI unsigned xb_ld(unsigned* p)              { return __hip_atomic_load(p, __ATOMIC_RELAXED, __HIP_MEMORY_SCOPE_AGENT); }
DI unsigned xb_add(unsigned* p, unsigned v) { return __hip_atomic_fetch_add(p, v, __ATOMIC_RELAXED, __HIP_MEMORY_SCOPE_AGENT); }
DI unsigned xb_xcc_id() { return (unsigned)__builtin_amdgcn_s_getreg((3 << 11) | 20) & 0xFu; }
#define XB_SPIN(cond, bar) do { while (cond) __builtin_amdgcn_s_sleep(1); } while (0)
DI void xcd_barrier_complete(unsigned* bar, unsigned x, unsigned& nloc, unsigned& nx) {
    const unsigned G = gridDim.x;
    unsigned sum, cnt, mine;
    for (;;) {
        sum = 0u; cnt = 0u; mine = 0u;
#pragma unroll
        for (unsigned j = 0; j < 16; ++j) { const unsigned c = xb_ld(&bar[XB_XCNT(j)]); sum += c; cnt += (c > 0u) ? 1u : 0u; mine = (j == x) ? c : mine; }
        if (sum == G) break;
        __builtin_amdgcn_s_sleep(1);
    }
    nloc = mine > 0u ? mine : 1u; nx = cnt > 0u ? cnt : 1u;
}
DI void xcd_barrier(unsigned* bar, unsigned x, volatile LAS unsigned* st, bool leader_thread) {
    asm volatile("s_waitcnt vmcnt(0)" ::: "memory");
    __syncthreads();
    if (leader_thread) {
        __builtin_amdgcn_s_waitcnt(0);
        unsigned nloc = st[0], nx = st[1];
        if (nloc == 0u) { xcd_barrier_complete(bar, x, nloc, nx); st[0] = nloc; st[1] = nx; }
        const unsigned old = xb_add(&bar[XB_XSUB(x)], 1u);
        const unsigned gen = old / nloc;
        if (old + 1u == (gen + 1u) * nloc) {
            __builtin_amdgcn_fence(__ATOMIC_RELEASE, "agent");
            asm volatile("s_waitcnt vmcnt(0)" ::: "memory");
            const unsigned og = xb_add(&bar[XB_TOP], 1u);
            const unsigned tg = og / nx;
            if (og + 1u == (tg + 1u) * nx) xb_add(&bar[XB_TOPGEN], 1u);
            else XB_SPIN(xb_ld(&bar[XB_TOPGEN]) == tg, bar);
            __builtin_amdgcn_fence(__ATOMIC_ACQUIRE, "agent");
            xb_add(&bar[XB_XGEN(x)], 1u);
            asm volatile("s_waitcnt vmcnt(0)" ::: "memory");
        } else {
            XB_SPIN(xb_ld(&bar[XB_XGEN(x)]) == gen, bar);
            __builtin_amdgcn_fence(__ATOMIC_ACQUIRE, "agent");
            asm volatile("s_waitcnt vmcnt(0)" ::: "memory");
        }
    }
    __syncthreads();
}

constexpr int NPHASES = 37;

DI int phase_kind(int ph) {
    if (ph == 0) return 0;
    const int q = (ph - 1) % 18; if (q == 0) return 3; if (q == 17) return 0;
    const int l = (q - 1) >> 2, s = (q - 1) & 3;
    if ((l & 1) == 0) return s == 0 ? 1 : s == 1 ? 2 : s == 2 ? 3 : 4;
    return s == 0 ? 5 : s == 1 ? 6 : s == 2 ? 7 : 4;
}
DI void run_phase(LAS unsigned char* lds, const Params& P, int ph, int wave_s, bool dry) {
    int tid0;
    asm volatile("v_mbcnt_lo_u32_b32 %0, -1, 0\n\tv_mbcnt_hi_u32_b32 %0, -1, %0" : "=v"(tid0));
    tid0 += wave_s * 64;
    if (ph == 0) { wprep_phase(lds, P, tid0); xprep_phase(P, 0, tid0); return; }
    const int half = (ph - 1) / 18, q = (ph - 1) % 18;
    if (q == 0) return;
    if (q == 17) { final_phase(P, half, tid0, dry); if (half == 0 && !dry) xprep_phase(P, 1, tid0); return; }
    const int l = (q - 1) >> 2, s = (q - 1) & 3;
    unsigned char* ws = P.ws;
    const int* pos = P.pos + (size_t)half * TH;
    if ((l & 1) == 0) {
        const int li = l >> 1;
        unsigned char* wb = ws + W_RET + (size_t)li * 16 * MiB;
        if (s == 1) { if (EN_SCAN) scan_phase(lds, P, tid0, dry); return; }
        if (s == 2) { gnorm_phase(P, tid0, dry); return; }
        const int ng = s == 0 ? 2 : 1;
        for (int gi = 0; gi < ng; ++gi) {
            GemmD g{};
            g.pos = pos; g.ssq_in = (const float*)(ws + ((half == 1 && l == 0) ? O_SSQH2 : O_SSQH));
            if (s == 0 && gi == 0) {
                g.A = (const bf16_t*)(ws + O_HB); g.Bt = (const bf16_t*)wb; g.lda = 1024; g.ldb = 1024; g.K = 1024; g.nM = 64; g.nN = 16; g.bskip_from = 8; g.bskip_add = 8; g.epi = E_RETQG;
                g.o0 = (bf16_t*)(ws + O_RQ); g.o1 = (bf16_t*)(ws + O_RK); g.o2 = (bf16_t*)(ws + O_G);
            } else if (s == 0) {
                g.A = (const bf16_t*)wb + (size_t)2048 * 1024; g.Bt = (const bf16_t*)(ws + O_HB); g.lda = 1024; g.ldb = 1024; g.K = 1024; g.nM = 8; g.nN = 64; g.bskip_from = 1 << 30; g.epi = E_VB;
                g.o1 = (bf16_t*)(ws + O_RVT); g.lg2a = 1.0f;
            } else {
                g.A = (const bf16_t*)(ws + O_G); g.Bt = (const bf16_t*)(wb + 12 * MiB); g.lda = 2048; g.ldb = 2048; g.K = 2048; g.nM = 64; g.nN = 4; g.bskip_from = 1 << 30; g.epi = E_OUT;
                g.kscale = (const float*)(ws + O_SSQO);
                g.hin = (l == 0 ? P.x : P.out) + (size_t)half * TH * DM; g.hout = P.out + (size_t)half * TH * DM;
                g.o0 = (bf16_t*)(ws + O_HB); g.ssq_out = (float*)(ws + O_SSQH);
                if (dry) { g.hout = (float*)(ws + O_DUMMY); g.o0 = (bf16_t*)(ws + O_DUMMY + 64 * MiB); g.ssq_out = (float*)(ws + O_DUMMY + 96 * MiB); }
            }
            if (EN_GEMM) gemm_phase(lds, g, tid0);
        }
    } else {
        const int li = l >> 1;
        unsigned char* wb = ws + W_MLA + (size_t)li * W_MLA_SZ;
        if (s == 2) { if (EN_ATTN) attn_phase(lds, P, tid0, dry); return; }
        const int ng = s == 1 ? 3 : 1;
        for (int gi = 0; gi < ng; ++gi) {
            GemmD g{};
            g.pos = pos; g.bskip_from = 1 << 30;
            if (s == 0) {
                g.A = (const bf16_t*)(ws + O_HB); g.Bt = (const bf16_t*)wb; g.lda = 1024; g.ldb = 1024; g.K = 1024; g.nM = 64; g.nN = 10; g.epi = E_MLAIN;
                g.ssq_in = (const float*)(ws + O_SSQH); g.o0 = (bf16_t*)(ws + O_LAT); g.o1 = (bf16_t*)(ws + O_KROPE); g.o2 = (bf16_t*)(ws + O_G);
                g.ssq_out = (float*)(ws + O_SSQQ); g.ssq_out2 = (float*)(ws + O_SSQKV);
            } else if (s == 1 && gi == 0) {
                g.A = (const bf16_t*)(ws + O_LAT); g.Bt = (const bf16_t*)(wb + 5 * MiB); g.lda = 384; g.ldb = 256; g.K = 256; g.nM = 64; g.nN = 12; g.epi = E_QB;
                g.ssq_in = (const float*)(ws + O_SSQQ); g.o0 = (bf16_t*)(ws + O_MQ);
            } else if (s == 1 && gi == 1) {
                g.A = (const bf16_t*)(ws + O_LAT) + 256; g.Bt = (const bf16_t*)(wb + 6 * MiB + MiB / 2); g.lda = 384; g.ldb = 128; g.K = 128; g.nM = 64; g.nN = 8; g.epi = E_KB;
                g.ssq_in = (const float*)(ws + O_SSQKV); g.o0 = (bf16_t*)(ws + O_KN);
            } else if (s == 1) {
                g.A = (const bf16_t*)(wb + 7 * MiB + MiB / 2); g.Bt = (const bf16_t*)(ws + O_LAT) + 256; g.lda = 128; g.ldb = 384; g.K = 128; g.nM = 8; g.nN = 64; g.epi = E_VB;
                g.ssq_in = (const float*)(ws + O_SSQKV); g.o1 = (bf16_t*)(ws + O_MVT);
            } else {
                g.A = (const bf16_t*)(ws + O_G); g.Bt = (const bf16_t*)(wb + 8 * MiB + MiB / 2); g.lda = 2048; g.ldb = 2048; g.K = 2048; g.nM = 64; g.nN = 4; g.epi = E_OUT;
                g.hin = P.out + (size_t)half * TH * DM; g.hout = P.out + (size_t)half * TH * DM;
                g.o0 = l == 3 ? nullptr : (bf16_t*)(ws + O_HB); g.ssq_out = (float*)(ws + O_SSQH);
                if (dry) { g.hout = (float*)(ws + O_DUMMY); g.o0 = (bf16_t*)(ws + O_DUMMY + 64 * MiB); g.ssq_out = (float*)(ws + O_DUMMY + 96 * MiB); }
            }
            if (EN_GEMM) gemm_phase(lds, g, tid0);
        }
    }
}

__global__ void __launch_bounds__(512, 2) trunk_megakernel(Params P) {
    extern __shared__ __attribute__((aligned(16))) unsigned char shm[];
    LAS unsigned char* lds = (LAS unsigned char*)shm;
    cg::grid_group grid = cg::this_grid();
    const int wave_s = __builtin_amdgcn_readfirstlane((int)(threadIdx.x >> 6));
    volatile LAS unsigned* st = (volatile LAS unsigned*)(lds + LDS_BYTES);
    unsigned* bar = (unsigned*)(P.ws + O_BAR);
    const unsigned xcc = xb_xcc_id();
    const bool use_xb = P.ph_hi - P.ph_lo > 1;
    if (use_xb) {
        if (threadIdx.x == 0) { st[0] = 0u; st[1] = 0u; (void)xb_add(&bar[XB_XCNT(xcc)], 1u); }
        __syncthreads();
    }
    const int ph_hi = __builtin_amdgcn_readfirstlane(P.ph_hi), ph_lo = __builtin_amdgcn_readfirstlane(P.ph_lo);
    int ph = ph_lo;
    if (ph < ph_hi) for (;;) {
        int nrep = (PROBE_DUP && ((PROBE_DUP >> phase_kind(ph)) & 2)) ? 2 : 1;
        if (phase_kind(ph) == 3) nrep = 0;
        if (nrep > 0) for (;;) {
            --nrep;
            run_phase(lds, P, ph, wave_s, nrep > 0);
            if (nrep > 0 || ph + 1 < ph_hi) {
                if (ph_lo < 0) grid.sync();
                else {
                    int l0; asm volatile("v_mbcnt_lo_u32_b32 %0, -1, 0\n\tv_mbcnt_hi_u32_b32 %0, -1, %0" : "=v"(l0));
                    for (int k = 0; k < 1 + (PROBE_DUP & 1); ++k) xcd_barrier(bar, xcc, st, wave_s == 0 && l0 == 0);
                }
            }
            nrep = __builtin_amdgcn_readfirstlane(nrep);
            if (nrep <= 0) break;
        }
        ph = __builtin_amdgcn_readfirstlane(ph + 1);
        if (ph >= ph_hi) break;
    }
}

extern "C" void kernel_launch(void* const* d_in, const int* in_sizes, int n_in, void* d_out, int out_size, void* d_ws, size_t ws_size, hipStream_t stream) {
    static int grid_blocks = 0;
    if (grid_blocks == 0) {
        if (n_in != 25 || ws_size < WS_NEED) { fprintf(stderr, "kernel_launch: unexpected n_in %d / ws %zu\n", n_in, ws_size); grid_blocks = -1; return; }
        int dev = 0, cus = 0, per_cu = 0;
        hipGetDevice(&dev);
        hipDeviceGetAttribute(&cus, hipDeviceAttributeMultiprocessorCount, dev);
        if (hipFuncSetAttribute((const void*)trunk_megakernel, hipFuncAttributeMaxDynamicSharedMemorySize, LDS_BYTES + 16) != hipSuccess) { fprintf(stderr, "hipFuncSetAttribute failed\n"); grid_blocks = -1; return; }
        hipOccupancyMaxActiveBlocksPerMultiprocessor(&per_cu, (const void*)trunk_megakernel, 512, LDS_BYTES + 16);
        if (per_cu < 1) per_cu = 1;
        if (per_cu > 1) per_cu = 1;
        grid_blocks = cus * per_cu;
        (void)hipGetLastError();
    }
    if (grid_blocks < 0) return;
    Params p{};
    p.x = (const float*)d_in[0]; p.pos = (const int*)d_in[1];
    p.lnorm[0] = (const float*)d_in[2]; p.ret_win[0] = (const float*)d_in[3]; p.ret_gn[0] = (const float*)d_in[4]; p.ret_wout[0] = (const float*)d_in[5];
    p.lnorm[1] = (const float*)d_in[6]; p.mla_win[0] = (const float*)d_in[7]; p.mla_qn[0] = (const float*)d_in[8]; p.mla_wqb[0] = (const float*)d_in[9];
    p.mla_kvn[0] = (const float*)d_in[10]; p.mla_wkvb[0] = (const float*)d_in[11]; p.mla_wout[0] = (const float*)d_in[12];
    p.lnorm[2] = (const float*)d_in[13]; p.ret_win[1] = (const float*)d_in[14]; p.ret_gn[1] = (const float*)d_in[15]; p.ret_wout[1] = (const float*)d_in[16];
    p.lnorm[3] = (const float*)d_in[17]; p.mla_win[1] = (const float*)d_in[18]; p.mla_qn[1] = (const float*)d_in[19]; p.mla_wqb[1] = (const float*)d_in[20];
    p.mla_kvn[1] = (const float*)d_in[21]; p.mla_wkvb[1] = (const float*)d_in[22]; p.mla_wout[1] = (const float*)d_in[23];
    p.fnorm = (const float*)d_in[24];
    p.out = (float*)d_out; p.ws = (unsigned char*)d_ws;
#if MULTI_LAUNCH
    for (int ph = 0; ph < NPHASES; ++ph) {
        p.ph_lo = ph; p.ph_hi = ph + 1;
        hipLaunchKernelGGL(trunk_megakernel, dim3(grid_blocks), dim3(512), LDS_BYTES + 16, stream, p);
    }
#else
    p.ph_lo = 0; p.ph_hi = NPHASES;
    if (hipMemsetAsync((char*)d_ws + O_BAR, 0, XCD_BAR_WORDS * 4, stream) != hipSuccess) { fprintf(stderr, "memset failed\n"); return; }
    void* args[] = {&p};
    hipError_t e = hipLaunchCooperativeKernel((const void*)trunk_megakernel, dim3(grid_blocks), dim3(512), args, LDS_BYTES + 16, stream);
    if (e != hipSuccess) fprintf(stderr, "cooperative launch failed: %s (grid %d)\n", hipGetErrorString(e), grid_blocks);
#endif
}
```

```cpp
#include <hip/hip_runtime.h>
#include <hip/hip_cooperative_groups.h>
#include <cstdio>
namespace cg = cooperative_groups;

#ifndef MULTI_LAUNCH
#define MULTI_LAUNCH 0
#endif

#ifndef PROBE_DUP
#define PROBE_DUP 0
#endif
#ifndef SCAN_SKIP
#define SCAN_SKIP 0
#endif
#ifndef EPI_MASK
#define EPI_MASK 127
#endif
#ifndef EN_GEMM
#define EN_GEMM 1
#endif
#ifndef EN_ATTN
#define EN_ATTN 1
#endif
#ifndef EN_SCAN
#define EN_SCAN 1
#endif
#define LAS __attribute__((address_space(3)))
#define DI __device__ __forceinline__
typedef unsigned short bf16_t;
typedef short bf16x8 __attribute__((ext_vector_type(8)));
typedef short s16x4 __attribute__((ext_vector_type(4)));
typedef float f32x4 __attribute__((ext_vector_type(4)));
typedef float f32x16 __attribute__((ext_vector_type(16)));
typedef unsigned u32x4 __attribute__((ext_vector_type(4)));
typedef unsigned u32x2 __attribute__((ext_vector_type(2)));

constexpr int TH = 16384;
constexpr int SEQ = 2048;
constexpr int DM = 1024;
constexpr int LDS_BYTES = 147456;
constexpr float EPS = 1e-6f;
constexpr float LOG2_1E4 = 13.287712379549449f;
constexpr float LOG2E = 1.4426950408889634f;
constexpr size_t MiB = (size_t)1 << 20;

constexpr size_t W_RET = 0;
constexpr size_t W_MLA = 32 * MiB;
constexpr size_t W_MLA_SZ = 12 * MiB + MiB / 2;
constexpr size_t O_HB = 57 * MiB;
constexpr size_t O_SSQH = 89 * MiB;
constexpr size_t O_G = 90 * MiB;
constexpr size_t O_RQ = 154 * MiB;
constexpr size_t O_RK = 186 * MiB;
constexpr size_t O_RKDT = 218 * MiB;
constexpr size_t O_RVT = 250 * MiB;
constexpr size_t O_SSQO = 314 * MiB;
constexpr size_t O_LAT = 154 * MiB;
constexpr size_t O_KROPE = 166 * MiB;
constexpr size_t O_SSQQ = 168 * MiB;
constexpr size_t O_SSQKV = 168 * MiB + MiB / 4;
constexpr size_t O_MQ = 169 * MiB;
constexpr size_t O_KN = 265 * MiB;
constexpr size_t O_MVT = 329 * MiB;
constexpr size_t WS_NEED = 393 * MiB;
constexpr size_t O_SSQH2 = 395 * MiB;
constexpr size_t O_BAR = 396 * MiB;
constexpr size_t O_DUMMY = 400 * MiB;

struct Params {
    const float* x; const int* pos;
    const float* lnorm[4];
    const float* ret_win[2]; const float* ret_gn[2]; const float* ret_wout[2];
    const float* mla_win[2]; const float* mla_qn[2]; const float* mla_wqb[2]; const float* mla_kvn[2]; const float* mla_wkvb[2]; const float* mla_wout[2];
    const float* fnorm;
    float* out; unsigned char* ws;
    int ph_lo, ph_hi;
};

DI unsigned pk2(float lo, float hi) {
    typedef __bf16 bf2 __attribute__((ext_vector_type(2)));
    typedef float f2 __attribute__((ext_vector_type(2)));
    f2 v = {lo, hi};
    bf2 b = __builtin_convertvector(v, bf2);
    return __builtin_bit_cast(unsigned, b);
}
DI float bflo(unsigned u) { return __uint_as_float(u << 16); }
DI float bfhi(unsigned u) { return __uint_as_float(u & 0xffff0000u); }
DI float fexp2(float x) { return __builtin_amdgcn_exp2f(x); }
DI void sincos_rev(float ang, float& s, float& c) {
    float rev = ang * 0.15915494309189535f;
    rev = __builtin_amdgcn_fractf(rev);
    s = __builtin_amdgcn_sinf(rev);
    c = __builtin_amdgcn_cosf(rev);
}
DI float silu(float x) { return x * __builtin_amdgcn_rcpf(1.0f + fexp2(-x * LOG2E)); }
DI float rstd_parts(const float* p, int nparts4, float invn) {
    float s = 0.f;
    for (int i = 0; i < nparts4; ++i) { f32x4 v = *(const f32x4*)(p + 4 * i); s += (v.x + v.y) + (v.z + v.w); }
    return __builtin_amdgcn_rsqf(s * invn + EPS);
}
DI u32x4 pack8(const f32x4& a, const f32x4& b, float sc) {
    u32x4 w; w.x = pk2(a[0] * sc, a[1] * sc); w.y = pk2(a[2] * sc, a[3] * sc); w.z = pk2(b[0] * sc, b[1] * sc); w.w = pk2(b[2] * sc, b[3] * sc); return w;
}
#define MFMA32(a, b, c) __builtin_amdgcn_mfma_f32_32x32x16_bf16((a), (b), (c), 0, 0, 0)
DI bf16x8 pack_step(const f32x16& x, int s) {
    u32x4 p;
    p.x = pk2(x[8 * s + 0], x[8 * s + 1]); p.y = pk2(x[8 * s + 2], x[8 * s + 3]); p.z = pk2(x[8 * s + 4], x[8 * s + 5]); p.w = pk2(x[8 * s + 6], x[8 * s + 7]);
    return __builtin_bit_cast(bf16x8, p);
}

namespace pg8 {
constexpr int BM = 256, BK = 64, HALF = 128, HTB = HALF * BK * 2, NXCD = 8, WGM = 8;
DI int lds_byte(int r, int c) { const int st = (r >> 4) * 2 + (c >> 5), rr = r & 15, cc = c & 31, ob = rr * 64 + cc * 2; return st * 1024 + (ob ^ (((ob >> 9) & 1) << 5)); }
DI void stage_rc(int b, int& R, int& C) { const int st = b / 1024, sb = b % 1024, swz = sb ^ (((sb >> 9) & 1) << 5); R = (st >> 1) * 16 + swz / 64; C = (st & 1) * 32 + (swz % 64) / 2; }
DI int perm32(int rho) { const int n = rho >> 4, i = rho & 15; return 8 * (i >> 2) + 4 * n + (i & 3); }
struct Unit { int pm, pn; };
struct StaticOrder {
    int nM, nN, nwg, G, c;
    DI void init(int nM_, int nN_, int G_, int c_) { nM = nM_; nN = nN_; nwg = nM * nN; G = G_; c = c_; }
    DI bool next(int i, Unit& u) const {
        const long L = (long)i * G + c; if (L >= nwg) return false;
        int wgid = (int)L; { const int q = nwg / NXCD, r = nwg % NXCD, xcd = wgid % NXCD, off = wgid / NXCD; wgid = (xcd < r ? xcd * (q + 1) : r * (q + 1) + (xcd - r) * q) + off; }
        const int nig = WGM * nN, gid = wgid / nig, fm = gid * WGM, gsz = (nM - fm) < WGM ? (nM - fm) : WGM;
        u.pm = fm + ((wgid % nig) % gsz); u.pn = (wgid % nig) / gsz; return true;
    }
};
}

enum { E_RETQG = 0, E_RETT, E_OUT, E_MLAIN, E_QB, E_KB, E_VB };
struct GemmD {
    const bf16_t* A; const bf16_t* Bt; int lda, ldb, K, nM, nN, bskip_from, bskip_add, epi;
    const int* pos;
    const float* ssq_in;
    float* ssq_out; float* ssq_out2;
    bf16_t* o0; bf16_t* o1; bf16_t* o2;
    const float* hin; float* hout;
    float lg2a, lg2b, lg2c, lg2d;
    const float* kscale;
};

typedef f32x4 AccT[2][2][4][2];

DI void rope_pair8(const f32x4& a0, const f32x4& a1, const f32x4& b0, const f32x4& b1, float rs, float posf, int i0, float fexp, float osc, u32x4& lo, u32x4& hi) {
#pragma unroll
    for (int e2 = 0; e2 < 4; ++e2) {
        float o0[2], o1[2];
#pragma unroll
        for (int t = 0; t < 2; ++t) {
            const int e = 2 * e2 + t;
            const float v0 = (e < 4 ? a0[e & 3] : a1[e & 3]) * rs, v1 = (e < 4 ? b0[e & 3] : b1[e & 3]) * rs;
            const float invf = fexp2(-(float)(i0 + e) * fexp);
            float sn, cs; sincos_rev(posf * invf, sn, cs);
            o0[t] = (v0 * cs - v1 * sn) * osc; o1[t] = (v1 * cs + v0 * sn) * osc;
        }
        lo[e2] = pk2(o0[0], o0[1]); hi[e2] = pk2(o1[0], o1[1]);
        if (e2 & 1) __builtin_amdgcn_sched_barrier(0);
    }
}

DI void row_stats(const GemmD& g, int pm, int wr, int fr, int fq, bool p16, float invn, float (&rsr)[2][4], int (&posr)[2][4]) {
    f32x4 pv[2][4];
#pragma unroll
    for (int ai = 0; ai < 2; ++ai)
#pragma unroll
        for (int m = 0; m < 4; ++m) {
            const int row = pm * 256 + ai * 128 + wr * 64 + m * 16 + fr;
            pv[ai][m] = p16 ? *(const f32x4*)(g.ssq_in + (size_t)row * 16 + 4 * fq) : *(const f32x4*)(g.ssq_in + (size_t)row * 4);
            posr[ai][m] = g.pos[row];
        }
#pragma unroll
    for (int ai = 0; ai < 2; ++ai)
#pragma unroll
        for (int m = 0; m < 4; ++m) {
            float sm = (pv[ai][m].x + pv[ai][m].y) + (pv[ai][m].z + pv[ai][m].w);
            if (p16) { sm += __shfl_xor(sm, 16); sm += __shfl_xor(sm, 32); }
            rsr[ai][m] = __builtin_amdgcn_rsqf(sm * invn + EPS);
        }
}

DI void gemm_epilogue(const GemmD& g, const AccT& acc, const pg8::Unit& u, int wr, int wc, int fr_, int fq_) {
    const int pm = u.pm, pn = u.pn;
    int fr = fr_, fq = fq_;
    asm volatile("" : "+v"(fr), "+v"(fq));
    const int cw = 32 * wc + 8 * fq;
    float rsr[2][4]; int posr[2][4];
    if (((EPI_MASK >> E_RETQG) & 1) && g.epi == E_RETQG) {
        row_stats(g, pm, wr, fr, fq, true, 1.0f / 1024.0f, rsr, posr);
#pragma unroll
        for (int ai = 0; ai < 2; ++ai)
#pragma unroll
            for (int m = 0; m < 4; ++m) {
                const int row = pm * 256 + ai * 128 + wr * 64 + m * 16 + fr;
                const float rs = rsr[ai][m];
                if (pn < 8) {
                    const int head = pn & 3; const bool isk = pn >= 4;
                    bf16_t* dst = isk ? g.o1 + (size_t)row * 1024 + head * 256 + cw
                                      : g.o0 + ((((size_t)(row >> 5) * 4 + head) * 16 + (cw >> 4)) * 512 + (((cw >> 3) & 1) * 32 + (row & 31)) * 8);
                    const int dst_hi = isk ? 128 : 8 * 512;
                    u32x4 lo, hi;
                    rope_pair8(acc[ai][0][m][0], acc[ai][0][m][1], acc[ai][1][m][0], acc[ai][1][m][1], rs, (float)posr[ai][m], cw, LOG2_1E4 / 128.0f, isk ? 0.0625f : 1.0f, lo, hi);
                    *(u32x4*)dst = lo; *(u32x4*)(dst + dst_hi) = hi;
                } else {
                    bf16_t* dst = g.o2 + (size_t)row * 2048 + (pn - 8) * 256 + cw;
#pragma unroll
                    for (int bj = 0; bj < 2; ++bj) *(u32x4*)(dst + bj * 128) = pack8(acc[ai][bj][m][0], acc[ai][bj][m][1], rs);
                }
            }
    } else if (((EPI_MASK >> E_RETT) & 1) && g.epi == E_RETT) {
        const float lg2 = pm == 0 ? g.lg2a : pm == 1 ? g.lg2b : pm == 2 ? g.lg2c : g.lg2d;
#pragma unroll
        for (int bj = 0; bj < 2; ++bj) {
            const int tok0 = pn * 256 + bj * 128 + cw;
            float rs[8], pf[8];
#pragma unroll
            for (int e = 0; e < 8; ++e) { rs[e] = g.ssq_in[(size_t)(tok0 + e) * 16 + fr]; pf[e] = (float)g.pos[tok0 + e]; }
#pragma unroll
            for (int e = 0; e < 8; ++e) {
                float sm = rs[e];
                sm += __shfl_xor(sm, 1); sm += __shfl_xor(sm, 2); sm += __shfl_xor(sm, 4); sm += __shfl_xor(sm, 8);
                rs[e] = __builtin_amdgcn_rsqf(sm * (1.0f / 1024.0f) + EPS) * fexp2((float)(127 - ((tok0 + e) & 127)) * lg2) * 0.0625f;
            }
#pragma unroll
            for (int m = 0; m < 4; ++m) {
                const int i = wr * 64 + m * 16 + fr;
                const float invf = fexp2(-(float)i * (LOG2_1E4 / 128.0f));
                u32x4 lo, hi;
#pragma unroll
                for (int e2 = 0; e2 < 4; ++e2) {
                    float o0[2], o1[2];
#pragma unroll
                    for (int t = 0; t < 2; ++t) {
                        const int e = 2 * e2 + t;
                        const float v0 = acc[0][bj][m][e >> 2][e & 3] * rs[e], v1 = acc[1][bj][m][e >> 2][e & 3] * rs[e];
                        float sn, cs; sincos_rev(pf[e] * invf, sn, cs);
                        o0[t] = v0 * cs - v1 * sn; o1[t] = v1 * cs + v0 * sn;
                    }
                    lo[e2] = pk2(o0[0], o0[1]); hi[e2] = pk2(o1[0], o1[1]);
                    __builtin_amdgcn_sched_barrier(0);
                }
                *(u32x4*)(g.o0 + (size_t)(pm * 256 + i) * TH + tok0) = lo;
                *(u32x4*)(g.o0 + (size_t)(pm * 256 + 128 + i) * TH + tok0) = hi;
            }
        }
    } else if (((EPI_MASK >> E_VB) & 1) && g.epi == E_VB) {
        const bool hstat = g.lg2a > 0.f;
#pragma unroll
        for (int bj = 0; bj < 2; ++bj) {
            const int tok0 = pn * 256 + bj * 128 + cw;
            float rs[8];
#pragma unroll
            for (int e = 0; e < 8; ++e) rs[e] = hstat ? g.ssq_in[(size_t)(tok0 + e) * 16 + fr] : g.ssq_in[(size_t)(tok0 + e) * 4 + (fr & 3)];
#pragma unroll
            for (int e = 0; e < 8; ++e) {
                float sm = rs[e];
                sm += __shfl_xor(sm, 1); sm += __shfl_xor(sm, 2);
                if (hstat) { sm += __shfl_xor(sm, 4); sm += __shfl_xor(sm, 8); }
                rs[e] = __builtin_amdgcn_rsqf(sm * (hstat ? 1.0f / 1024.0f : 1.0f / 128.0f) + EPS);
            }
#pragma unroll
            for (int ai = 0; ai < 2; ++ai)
#pragma unroll
                for (int m = 0; m < 4; ++m) {
                    const int frow = pm * 256 + ai * 128 + wr * 64 + m * 16 + fr;
                    const f32x4 a = acc[ai][bj][m][0], b = acc[ai][bj][m][1];
                    u32x4 w; w.x = pk2(a[0] * rs[0], a[1] * rs[1]); w.y = pk2(a[2] * rs[2], a[3] * rs[3]);
                    w.z = pk2(b[0] * rs[4], b[1] * rs[5]); w.w = pk2(b[2] * rs[6], b[3] * rs[7]);
                    *(u32x4*)(g.o1 + (size_t)frow * TH + tok0) = w;
                }
        }
    } else if (((EPI_MASK >> E_OUT) & 1) && g.epi == E_OUT) {
#pragma unroll
        for (int ai = 0; ai < 2; ++ai)
#pragma unroll
            for (int mp = 0; mp < 2; ++mp) {
                f32x4 hv[2][2][2];
#pragma unroll
                for (int mm = 0; mm < 2; ++mm)
#pragma unroll
                    for (int bj = 0; bj < 2; ++bj) {
                        const size_t off = (size_t)(pm * 256 + ai * 128 + wr * 64 + (2 * mp + mm) * 16 + fr) * 1024 + pn * 256 + bj * 128 + cw;
                        hv[mm][bj][0] = *(const f32x4*)(g.hin + off); hv[mm][bj][1] = *(const f32x4*)(g.hin + off + 4);
                    }
#pragma unroll
                for (int mm = 0; mm < 2; ++mm) {
                    const int m = 2 * mp + mm;
                    const int row = pm * 256 + ai * 128 + wr * 64 + m * 16 + fr;
                    float ss = 0.f;
#pragma unroll
                    for (int bj = 0; bj < 2; ++bj) {
                        const size_t off = (size_t)row * 1024 + pn * 256 + bj * 128 + cw;
                        const f32x4 h0 = hv[mm][bj][0] + acc[ai][bj][m][0], h1 = hv[mm][bj][1] + acc[ai][bj][m][1];
                        *(f32x4*)(g.hout + off) = h0; *(f32x4*)(g.hout + off + 4) = h1;
                        if (g.o0) *(u32x4*)(g.o0 + off) = pack8(h0, h1, 1.0f);
                        ss += (h0.x * h0.x + h0.y * h0.y) + (h0.z * h0.z + h0.w * h0.w) + (h1.x * h1.x + h1.y * h1.y) + (h1.z * h1.z + h1.w * h1.w);
                    }
                    ss += __shfl_xor(ss, 16); ss += __shfl_xor(ss, 32);
                    if (fq == 0) g.ssq_out[(size_t)row * 16 + pn * 4 + wc] = ss;
                }
            }
    } else if (((EPI_MASK >> E_MLAIN) & 1) && g.epi == E_MLAIN) {
        row_stats(g, pm, wr, fr, fq, true, 1.0f / 1024.0f, rsr, posr);
#pragma unroll
        for (int ai = 0; ai < 2; ++ai)
#pragma unroll
            for (int m = 0; m < 4; ++m) {
                const int row = pm * 256 + ai * 128 + wr * 64 + m * 16 + fr;
                const float rs = rsr[ai][m];
                if (pn == 0) {
                    float ss = 0.f;
#pragma unroll
                    for (int bj = 0; bj < 2; ++bj) {
                        const f32x4 a = acc[ai][bj][m][0] * rs, b = acc[ai][bj][m][1] * rs;
                        *(u32x4*)(g.o0 + (size_t)row * 384 + bj * 128 + cw) = pack8(a, b, 1.0f);
                        ss += (a.x * a.x + a.y * a.y) + (a.z * a.z + a.w * a.w) + (b.x * b.x + b.y * b.y) + (b.z * b.z + b.w * b.w);
                    }
                    ss += __shfl_xor(ss, 16); ss += __shfl_xor(ss, 32);
                    if (fq == 0) g.ssq_out[(size_t)row * 4 + wc] = ss;
                } else if (pn == 1) {
                    float ss = 0.f;
                    if (wc == 0) {
                        u32x4 lo, hi;
                        rope_pair8(acc[ai][0][m][0], acc[ai][0][m][1], acc[ai][1][m][0], acc[ai][1][m][1], rs, (float)posr[ai][m], 8 * fq, LOG2_1E4 / 32.0f, 1.0f, lo, hi);
                        *(u32x4*)(g.o1 + (size_t)row * 64 + 8 * fq) = lo; *(u32x4*)(g.o1 + (size_t)row * 64 + 32 + 8 * fq) = hi;
                    } else {
                        {
                            const f32x4 a = acc[ai][0][m][0] * rs, b = acc[ai][0][m][1] * rs;
                            *(u32x4*)(g.o0 + (size_t)row * 384 + 256 + cw - 32) = pack8(a, b, 1.0f);
                            ss += (a.x * a.x + a.y * a.y) + (a.z * a.z + a.w * a.w) + (b.x * b.x + b.y * b.y) + (b.z * b.z + b.w * b.w);
                        }
                        if (wc == 1) {
                            const f32x4 a = acc[ai][1][m][0] * rs, b = acc[ai][1][m][1] * rs;
                            *(u32x4*)(g.o0 + (size_t)row * 384 + 256 + 96 + 8 * fq) = pack8(a, b, 1.0f);
                            ss += (a.x * a.x + a.y * a.y) + (a.z * a.z + a.w * a.w) + (b.x * b.x + b.y * b.y) + (b.z * b.z + b.w * b.w);
                        }
                    }
                    ss += __shfl_xor(ss, 16); ss += __shfl_xor(ss, 32);
                    if (fq == 0) g.ssq_out2[(size_t)row * 4 + wc] = ss;
                } else {
                    bf16_t* dst = g.o2 + (size_t)row * 2048 + (pn - 2) * 256 + cw;
#pragma unroll
                    for (int bj = 0; bj < 2; ++bj) *(u32x4*)(dst + bj * 128) = pack8(acc[ai][bj][m][0], acc[ai][bj][m][1], rs);
                }
            }
    } else if (((EPI_MASK >> E_QB) & 1) && g.epi == E_QB) {
        row_stats(g, pm, wr, fr, fq, false, 1.0f / 256.0f, rsr, posr);
        const float qscale = 0.07216878364870322f * LOG2E;
#pragma unroll
        for (int ai = 0; ai < 2; ++ai)
#pragma unroll
            for (int m = 0; m < 4; ++m) {
                const int row = pm * 256 + ai * 128 + wr * 64 + m * 16 + fr;
                const float rs = rsr[ai][m] * qscale;
                if (pn < 8) {
#pragma unroll
                    for (int bj = 0; bj < 2; ++bj)
                        *(u32x4*)(g.o0 + ((size_t)row * 16 + 2 * pn + bj) * 192 + cw) = pack8(acc[ai][bj][m][0], acc[ai][bj][m][1], rs);
                } else {
                    const int head = 4 * (pn - 8) + wc;
                    u32x4 lo, hi;
                    rope_pair8(acc[ai][0][m][0], acc[ai][0][m][1], acc[ai][1][m][0], acc[ai][1][m][1], rs, (float)posr[ai][m], 8 * fq, LOG2_1E4 / 32.0f, 1.0f, lo, hi);
                    bf16_t* dst = g.o0 + ((size_t)row * 16 + head) * 192 + 128 + 8 * fq;
                    *(u32x4*)dst = lo; *(u32x4*)(dst + 32) = hi;
                }
            }
    } else if (((EPI_MASK >> E_KB) & 1) && g.epi == E_KB) {
        row_stats(g, pm, wr, fr, fq, false, 1.0f / 128.0f, rsr, posr);
#pragma unroll
        for (int ai = 0; ai < 2; ++ai)
#pragma unroll
            for (int m = 0; m < 4; ++m) {
                const int row = pm * 256 + ai * 128 + wr * 64 + m * 16 + fr;
                const float rs = rsr[ai][m];
#pragma unroll
                for (int bj = 0; bj < 2; ++bj)
                    *(u32x4*)(g.o0 + ((size_t)row * 16 + 2 * pn + bj) * 128 + cw) = pack8(acc[ai][bj][m][0], acc[ai][bj][m][1], rs);
            }
    }
}

DI void gemm_phase(LAS unsigned char* lds, const GemmD& g, int tid0) {
    using namespace pg8;
    const int tid = tid0, wid = __builtin_amdgcn_readfirstlane(tid >> 6), lane = tid & 63, wr = wid >> 2, wc = wid & 3, fr = lane & 15, fq = lane >> 4;
    const int K = g.K, nt = K / BK;
    StaticOrder S; S.init(g.nM, g.nN, (int)gridDim.x, (int)blockIdx.x);
    unsigned voffA, voffB;
    { int R, C; stage_rc(tid * 16, R, C); const int Rb = (R & ~31) + perm32(R & 31);
      voffA = (unsigned)(R * g.lda + C) * 2u; voffB = (unsigned)(Rb * g.ldb + C) * 2u; }
    const size_t pvoffA = (size_t)64 * g.lda * 2, pvoffB = (size_t)64 * g.ldb * 2;
    const size_t kstep = (size_t)(BK * 2);
    const size_t hstepA = (size_t)HALF * g.lda * 2, hstepB = (size_t)HALF * g.ldb * 2;
    const size_t tstepA = 2 * hstepA, tstepB = 2 * hstepB;
    const unsigned ldsw = (unsigned)wid * 1024u;
    const int aoff = lds_byte(wr * 64 + fr, fq * 8), boff = lds_byte(wc * 32 + fr, fq * 8);
#define PG8_SA(b, h) (((b) * 2 + (h)) * HTB)
#define PG8_SB(b, h) ((4 + (b) * 2 + (h)) * HTB)
#define PG8_STAGE(bufoff, gbase, voff) do { _Pragma("unroll") for (int _i = 0; _i < 2; ++_i) \
        __builtin_amdgcn_global_load_lds((const unsigned*)((const char*)(gbase) + _i * p##voff + voff), (LAS unsigned*)(lds + (bufoff) + ldsw + _i * 8192), 16, 0, 0); } while (0)
#define PG8_LDA(dst, b, h) do { _Pragma("unroll") for (int m = 0; m < 4; ++m) _Pragma("unroll") for (int k = 0; k < 2; ++k) dst[m][k] = *(const LAS bf16x8*)(lds + PG8_SA(b, h) + aoff + m * 2048 + k * 1024); } while (0)
#define PG8_LDB(dst, b, h) do { _Pragma("unroll") for (int n = 0; n < 2; ++n) _Pragma("unroll") for (int k = 0; k < 2; ++k) dst[n][k] = *(const LAS bf16x8*)(lds + PG8_SB(b, h) + boff + n * 2048 + k * 1024); } while (0)
#define PG8_MMA(ai, bj, At, Bt) do { __builtin_amdgcn_s_setprio(1); _Pragma("unroll") for (int m = 0; m < 4; ++m) _Pragma("unroll") for (int n = 0; n < 2; ++n) _Pragma("unroll") for (int k = 0; k < 2; ++k) \
        acc[ai][bj][m][n] = __builtin_amdgcn_mfma_f32_16x16x32_bf16(Bt[n][k], At[m][k], acc[ai][bj][m][n], 0, 0, 0); __builtin_amdgcn_s_setprio(0); } while (0)
#define PG8_WAIT_V(n) asm volatile("s_waitcnt vmcnt(" #n ")" ::: "memory")
#define PG8_WAIT_L(n) asm volatile("s_waitcnt lgkmcnt(" #n ")" ::: "memory")
#define PG8_BAR __builtin_amdgcn_s_barrier()
#define PG8_SCHED __builtin_amdgcn_sched_barrier(0)
#define PG8_BTILE(pn) ((pn) + ((pn) >= g.bskip_from ? g.bskip_add : 0))
    Unit cur, nxt; int ui = 0;
    if (!S.next(0, cur)) return;
    LAS float* ktab = (LAS float*)(lds + 131072 + wid * 2048);
#define PG8_KTAB(u_) do { if (g.kscale) { \
        _Pragma("unroll 1") for (int rr_ = 0; rr_ < 2; ++rr_) { const int rl_ = lane + 64 * rr_; \
            const int grow_ = (u_).pm * 256 + (rl_ >> 6) * 128 + wr * 64 + (rl_ & 63); float rprev_ = 0.f; \
            _Pragma("unroll 2") for (int h_ = 0; h_ < 4; ++h_) { const float* p_ = g.kscale + ((size_t)grow_ * 4 + h_) * 16; \
                const f32x4 a_ = *(const f32x4*)p_, b_ = *(const f32x4*)(p_ + 4), c_ = *(const f32x4*)(p_ + 8), d_ = *(const f32x4*)(p_ + 12); \
                const float sm_ = ((a_.x + a_.y) + (a_.z + a_.w)) + ((b_.x + b_.y) + (b_.z + b_.w)) + ((c_.x + c_.y) + (c_.z + c_.w)) + ((d_.x + d_.y) + (d_.z + d_.w)); \
                const float rc_ = __builtin_amdgcn_rsqf(sm_ * (1.0f / 512.0f) + EPS); \
                if (h_ > 0) ktab[(h_ - 1) * 128 + rl_] = rprev_ / rc_; \
                rprev_ = rc_; } \
            ktab[3 * 128 + rl_] = rprev_; } \
        asm volatile("s_waitcnt lgkmcnt(0)" ::: "memory"); } } while (0)
    PG8_KTAB(cur);
    AccT acc;
    float zz = 0.f; asm volatile("" : "+v"(zz));
#pragma unroll
    for (int a = 0; a < 2; ++a)
#pragma unroll
        for (int b = 0; b < 2; ++b)
#pragma unroll
            for (int m = 0; m < 4; ++m)
#pragma unroll
                for (int n = 0; n < 2; ++n) acc[a][b][m][n] = (f32x4){zz, zz, zz, zz};
    bf16x8 At[4][2], B0[2][2], B1[2][2];
    const char* cA = (const char*)g.A + (size_t)cur.pm * tstepA; const char* cB = (const char*)g.Bt + (size_t)PG8_BTILE(cur.pn) * tstepB;
    PG8_STAGE(PG8_SB(0, 0), cB, voffB); PG8_STAGE(PG8_SA(0, 0), cA, voffA); PG8_STAGE(PG8_SB(0, 1), cB + hstepB, voffB); PG8_STAGE(PG8_SA(0, 1), cA + hstepA, voffA);
    if (wr == 1) PG8_BAR;
    PG8_WAIT_V(4); PG8_BAR;
    PG8_STAGE(PG8_SB(1, 0), cB + kstep, voffB); PG8_STAGE(PG8_SA(1, 0), cA + kstep, voffA); PG8_STAGE(PG8_SB(1, 1), cB + hstepB + kstep, voffB);
    PG8_WAIT_V(6); PG8_BAR;
    for (;;) {
        const bool has_next = S.next(ui + 1, nxt);
        const char* nA = has_next ? (const char*)g.A + (size_t)nxt.pm * tstepA : cA; const char* nB = has_next ? (const char*)g.Bt + (size_t)PG8_BTILE(nxt.pn) * tstepB : cB;
        const int seglen = g.kscale ? 8 : nt;
        for (int t0 = 0; t0 < nt; t0 += seglen) {
        if (g.kscale && t0 > 0) {
            float rt[2][4];
#pragma unroll
            for (int a = 0; a < 2; ++a)
#pragma unroll
                for (int m = 0; m < 4; ++m) rt[a][m] = ktab[((t0 >> 3) - 1) * 128 + a * 64 + m * 16 + fr];
            asm volatile("s_waitcnt lgkmcnt(0)" ::: "memory");
#pragma unroll
            for (int a = 0; a < 2; ++a)
#pragma unroll
                for (int b = 0; b < 2; ++b)
#pragma unroll
                    for (int m = 0; m < 4; ++m)
#pragma unroll
                        for (int n = 0; n < 2; ++n) acc[a][b][m][n] *= rt[a][m];
        }
        for (int t = t0; t < t0 + seglen; t += 2) {
            const bool last = (t == nt - 2);
            const char* a1 = cA + (size_t)(t + 1) * kstep;
            const char* a2 = last ? nA : cA + (size_t)(t + 2) * kstep; const char* b2 = last ? nB : cB + (size_t)(t + 2) * kstep;
            const char* a3 = a2 + kstep; const char* b3 = b2 + kstep;
            PG8_LDB(B0, 0, 0); PG8_SCHED; PG8_LDA(At, 0, 0); PG8_STAGE(PG8_SA(1, 1), a1 + hstepA, voffA);
            PG8_WAIT_L(8); PG8_BAR; PG8_WAIT_L(0); PG8_MMA(0, 0, At, B0); PG8_BAR; PG8_SCHED;
            PG8_LDB(B1, 0, 1); PG8_STAGE(PG8_SB(0, 0), b2, voffB);
            PG8_BAR; PG8_WAIT_L(0); PG8_MMA(0, 1, At, B1); PG8_BAR;
            PG8_LDA(At, 0, 1); PG8_STAGE(PG8_SA(0, 0), a2, voffA);
            PG8_BAR; PG8_WAIT_L(0); PG8_MMA(1, 0, At, B0); PG8_BAR; PG8_SCHED;
            PG8_STAGE(PG8_SB(0, 1), b2 + hstepB, voffB);
            PG8_WAIT_V(6); PG8_BAR; PG8_MMA(1, 1, At, B1); PG8_BAR;
            PG8_LDB(B0, 1, 0); PG8_SCHED; PG8_LDA(At, 1, 0); PG8_STAGE(PG8_SA(0, 1), a2 + hstepA, voffA);
            PG8_WAIT_L(8); PG8_BAR; PG8_WAIT_L(0); PG8_MMA(0, 0, At, B0); PG8_BAR; PG8_SCHED;
            PG8_LDB(B1, 1, 1); PG8_STAGE(PG8_SB(1, 0), b3, voffB);
            PG8_BAR; PG8_WAIT_L(0); PG8_MMA(0, 1, At, B1); PG8_BAR;
            PG8_LDA(At, 1, 1); PG8_STAGE(PG8_SA(1, 0), a3, voffA);
            PG8_BAR; PG8_WAIT_L(0); PG8_MMA(1, 0, At, B0); PG8_BAR; PG8_SCHED;
            PG8_STAGE(PG8_SB(1, 1), b3 + hstepB, voffB);
            PG8_WAIT_V(6); PG8_BAR; PG8_MMA(1, 1, At, B1); PG8_BAR;
        }
        }
        if (g.kscale) {
            float rt[2][4];
#pragma unroll
            for (int a = 0; a < 2; ++a)
#pragma unroll
                for (int m = 0; m < 4; ++m) rt[a][m] = ktab[3 * 128 + a * 64 + m * 16 + fr];
            asm volatile("s_waitcnt lgkmcnt(0)" ::: "memory");
#pragma unroll
            for (int a = 0; a < 2; ++a)
#pragma unroll
                for (int b = 0; b < 2; ++b)
#pragma unroll
                    for (int m = 0; m < 4; ++m)
#pragma unroll
                        for (int n = 0; n < 2; ++n) acc[a][b][m][n] *= rt[a][m];
        }
        gemm_epilogue(g, acc, cur, wr, wc, fr, fq);
        if (!has_next) break;
        PG8_KTAB(nxt);
        asm volatile("" : "+v"(zz));
#pragma unroll
        for (int a = 0; a < 2; ++a)
#pragma unroll
            for (int b = 0; b < 2; ++b)
#pragma unroll
                for (int m = 0; m < 4; ++m)
#pragma unroll
                    for (int n = 0; n < 2; ++n) acc[a][b][m][n] = (f32x4){zz, zz, zz, zz};
        cur = nxt; cA = nA; cB = nB; ++ui;
    }
    PG8_WAIT_V(0);
    if (wr == 0) PG8_BAR;
    PG8_BAR;
}

struct WJob { const float* W; const float* gain; bf16_t* dst; int K, Nsrc, Nout, Kout, koff, map; };
DI int src_col(int map, int n) {
    if (map == 0) return n;
    if (map == 1) {
        if (n < 256) return n;
        if (n < 512) { const int c = n - 256;
            if (c < 32) return 384 + c; if (c < 128) return 256 + (c - 32); if (c < 160) return 384 + 32 + (c - 128); if (c < 192) return 256 + 96 + (c - 160); return -1; }
        return 448 + (n - 512);
    }
    if (map == 2) {
        const int pn = n >> 8, c = n & 255;
        if (pn < 8) return (2 * pn + (c >> 7)) * 192 + (c & 127);
        const int cl = c & 127; return (4 * (pn - 8) + (cl >> 5)) * 192 + 128 + (cl & 31) + ((c >> 7) ? 32 : 0);
    }
    if (map == 3) return (n >> 7) * 256 + (n & 127);
    return (n >> 7) * 256 + 128 + (n & 127);
}
DI WJob get_job(const Params& P, int j) {
    WJob w; w.koff = 0; w.map = 0; w.gain = nullptr;
    if (j < 4) { const int l = j >> 1; unsigned char* base = P.ws + W_RET + (size_t)l * 16 * MiB;
        if ((j & 1) == 0) { w.W = P.ret_win[l]; w.gain = P.lnorm[2 * l]; w.dst = (bf16_t*)base; w.K = 1024; w.Nsrc = 6144; w.Nout = 6144; w.Kout = 1024; }
        else { w.W = P.ret_wout[l]; w.gain = P.ret_gn[l]; w.dst = (bf16_t*)(base + 12 * MiB); w.K = 2048; w.Nsrc = 1024; w.Nout = 1024; w.Kout = 2048; }
        return w; }
    const int jj = j - 4, l = jj / 5, k = jj % 5; unsigned char* base = P.ws + W_MLA + (size_t)l * W_MLA_SZ;
    if (k == 0) { w.W = P.mla_win[l]; w.gain = P.lnorm[2 * l + 1]; w.dst = (bf16_t*)base; w.K = 1024; w.Nsrc = 2496; w.Nout = 2560; w.Kout = 1024; w.map = 1; }
    else if (k == 1) { w.W = P.mla_wqb[l]; w.gain = P.mla_qn[l]; w.dst = (bf16_t*)(base + 5 * MiB); w.K = 256; w.Nsrc = 3072; w.Nout = 3072; w.Kout = 256; w.map = 2; }
    else if (k == 2) { w.W = P.mla_wkvb[l]; w.gain = P.mla_kvn[l]; w.dst = (bf16_t*)(base + 6 * MiB + MiB / 2); w.K = 128; w.Nsrc = 4096; w.Nout = 2048; w.Kout = 128; w.koff = 0; w.map = 3; }
    else if (k == 3) { w.W = P.mla_wkvb[l]; w.gain = P.mla_kvn[l]; w.dst = (bf16_t*)(base + 7 * MiB + MiB / 2); w.K = 128; w.Nsrc = 4096; w.Nout = 2048; w.Kout = 128; w.koff = 0; w.map = 4; }
    else { w.W = P.mla_wout[l]; w.dst = (bf16_t*)(base + 8 * MiB + MiB / 2); w.K = 2048; w.Nsrc = 1024; w.Nout = 1024; w.Kout = 2048; }
    return w;
}
DI void wprep_phase(LAS unsigned char* lds, const Params& P, int tid0) {
    const int tid = tid0, wid = tid >> 6, lane = tid & 63;
    LAS float* scr = (LAS float*)(lds + wid * 8704);
    constexpr int NJ = 14;
    constexpr int cnt[NJ] = {3072, 1024, 3072, 1024, 1280, 384, 128, 128, 1024, 1280, 384, 128, 128, 1024};
    constexpr int NTOT = 2 * (3072 + 1024) + 2 * (1280 + 384 + 128 + 128 + 1024);
    for (int it0 = blockIdx.x * 8; it0 < NTOT; it0 += gridDim.x * 8) {
        int it = it0 + wid, j = 0;
        const bool live = it < NTOT;
        if (live) {
#pragma unroll
            for (int q = 0; q < NJ - 1; ++q) if (j == q && it >= cnt[q]) { it -= cnt[q]; j = q + 1; }
        }
        j = __builtin_amdgcn_readfirstlane(j); it = __builtin_amdgcn_readfirstlane(it);
        WJob w = get_job(P, live ? j : 0);
        const int nblk = w.Nout / 32;
        const int kb = it / nblk, nb = it % nblk, k0 = 64 * kb, n0 = 32 * nb;
        if (live) {
            const int sc = src_col(w.map, n0 + (lane & 31));
#pragma unroll 8
            for (int i = 0; i < 32; ++i) {
                const int kk = 2 * i + (lane >> 5), ks = k0 + kk - w.koff;
                float v = 0.f;
                if (sc >= 0 && ks >= 0) { v = w.W[(size_t)ks * w.Nsrc + sc]; if (w.gain) v *= w.gain[ks]; }
                scr[kk * 33 + (lane & 31)] = v;
            }
        }
        __syncthreads();
        if (live) {
            const int c = lane & 7;
#pragma unroll
            for (int jn = 0; jn < 4; ++jn) { const int n = (lane >> 3) + 8 * jn; const LAS float* sp = scr + (8 * c) * 33 + n;
                u32x4 o; o.x = pk2(sp[0 * 33], sp[1 * 33]); o.y = pk2(sp[2 * 33], sp[3 * 33]); o.z = pk2(sp[4 * 33], sp[5 * 33]); o.w = pk2(sp[6 * 33], sp[7 * 33]);
                *(u32x4*)(w.dst + (size_t)(n0 + n) * w.Kout + k0 + 8 * c) = o; }
        }
        __syncthreads();
    }
}

DI void xprep_phase(const Params& P, int half, int tid0) {
    const int wid = tid0 >> 6, lane = tid0 & 63;
    const float* x = P.x + (size_t)half * TH * DM;
    bf16_t* hb = (bf16_t*)(P.ws + O_HB); float* ssq = (float*)(P.ws + (half ? O_SSQH2 : O_SSQH));
    const int rstep = gridDim.x * 8;
    for (int row = blockIdx.x * 8 + wid; row < TH; row += 2 * rstep) {
        const int row2 = row + rstep; const bool has2 = row2 < TH; const int r2 = has2 ? row2 : row;
        const f32x4* xr = (const f32x4*)(x + (size_t)row * DM) + lane; const f32x4* xr2 = (const f32x4*)(x + (size_t)r2 * DM) + lane;
        f32x4 v[4], v2[4];
#pragma unroll
        for (int j = 0; j < 4; ++j) { v[j] = xr[64 * j]; v2[j] = xr2[64 * j]; }
        float s = 0.f, s2 = 0.f;
#pragma unroll
        for (int j = 0; j < 4; ++j) { s += (v[j].x * v[j].x + v[j].y * v[j].y) + (v[j].z * v[j].z + v[j].w * v[j].w);
            s2 += (v2[j].x * v2[j].x + v2[j].y * v2[j].y) + (v2[j].z * v2[j].z + v2[j].w * v2[j].w);
            u32x2 o; o.x = pk2(v[j].x, v[j].y); o.y = pk2(v[j].z, v[j].w); *((u32x2*)(hb + (size_t)row * DM) + lane + 64 * j) = o; }
        if (has2) {
#pragma unroll
            for (int j = 0; j < 4; ++j) { u32x2 o; o.x = pk2(v2[j].x, v2[j].y); o.y = pk2(v2[j].z, v2[j].w); *((u32x2*)(hb + (size_t)r2 * DM) + lane + 64 * j) = o; }
        }
#pragma unroll
        for (int o = 1; o < 64; o <<= 1) { s += __shfl_xor(s, o); s2 += __shfl_xor(s2, o); }
        if (lane < 16) { ssq[(size_t)row * 16 + lane] = lane == 0 ? s : 0.f; if (has2) ssq[(size_t)r2 * 16 + lane] = lane == 0 ? s2 : 0.f; }
    }
}

DI void gnorm_phase(const Params& P, int tid0, bool dry) {
    bf16_t* G = (bf16_t*)(P.ws + O_G); bf16_t* Go = (bf16_t*)(P.ws + (dry ? O_DUMMY : O_G)); const float* ssqo = (const float*)(P.ws + O_SSQO);
    const size_t nvec = (size_t)TH * 2048 / 8;
    for (size_t v = (size_t)blockIdx.x * 512 + tid0; v < nvec; v += (size_t)gridDim.x * 512) {
        const int row = (int)(v >> 8), c = (int)(v & 255) * 8, head = c >> 9;
        const float rs = rstd_parts(ssqo + ((size_t)row * 4 + head) * 16, 4, 1.0f / 512.0f);
        u32x4 w = *(u32x4*)(G + (size_t)row * 2048 + c);
        w.x = pk2(bflo(w.x) * rs, bfhi(w.x) * rs); w.y = pk2(bflo(w.y) * rs, bfhi(w.y) * rs); w.z = pk2(bflo(w.z) * rs, bfhi(w.z) * rs); w.w = pk2(bflo(w.w) * rs, bfhi(w.w) * rs);
        *(u32x4*)(Go + (size_t)row * 2048 + c) = w;
    }
}
DI void final_phase(const Params& P, int half, int tid0, bool dry) {
    float* h = P.out + (size_t)half * TH * DM; float* ho = dry ? (float*)(P.ws + O_DUMMY) : h; const float* ssq = (const float*)(P.ws + O_SSQH);
    const int wid = tid0 >> 6, lane = tid0 & 63;
    f32x4 gn[4];
#pragma unroll
    for (int j = 0; j < 4; ++j) gn[j] = *((const f32x4*)P.fnorm + lane + 64 * j);
    const int rstep = gridDim.x * 8;
    for (int row = blockIdx.x * 8 + wid; row < TH; row += 2 * rstep) {
        const int row2 = row + rstep; const bool has2 = row2 < TH; const int r2 = has2 ? row2 : row;
        float sm = ssq[(size_t)row * 16 + (lane & 15)], sm2 = ssq[(size_t)r2 * 16 + (lane & 15)];
        const f32x4* xr = (const f32x4*)(h + (size_t)row * DM) + lane; const f32x4* xr2 = (const f32x4*)(h + (size_t)r2 * DM) + lane;
        f32x4 v[4], v2[4];
#pragma unroll
        for (int j = 0; j < 4; ++j) { v[j] = xr[64 * j]; v2[j] = xr2[64 * j]; }
        sm += __shfl_xor(sm, 1); sm += __shfl_xor(sm, 2); sm += __shfl_xor(sm, 4); sm += __shfl_xor(sm, 8);
        sm2 += __shfl_xor(sm2, 1); sm2 += __shfl_xor(sm2, 2); sm2 += __shfl_xor(sm2, 4); sm2 += __shfl_xor(sm2, 8);
        const float rs = __builtin_amdgcn_rsqf(sm * (1.0f / 1024.0f) + EPS), rs2 = __builtin_amdgcn_rsqf(sm2 * (1.0f / 1024.0f) + EPS);
        f32x4* yr = (f32x4*)(ho + (size_t)row * DM) + lane; f32x4* yr2 = (f32x4*)(ho + (size_t)r2 * DM) + lane;
#pragma unroll
        for (int j = 0; j < 4; ++j) yr[64 * j] = v[j] * rs * gn[j];
        if (has2) {
#pragma unroll
            for (int j = 0; j < 4; ++j) yr2[64 * j] = v2[j] * rs2 * gn[j];
        }
    }
}

DI void attn_phase(LAS unsigned char* lds, const Params& P, int tid0, bool dry) {
    const size_t gdelta = dry ? (O_DUMMY - O_G) / 2 : 0;
    const bf16_t* MQ = (const bf16_t*)(P.ws + O_MQ); const bf16_t* KN = (const bf16_t*)(P.ws + O_KN);
    const bf16_t* KR = (const bf16_t*)(P.ws + O_KROPE); const bf16_t* MVT = (const bf16_t*)(P.ws + O_MVT); bf16_t* G = (bf16_t*)(P.ws + O_G);
    const int tid = tid0, wid = __builtin_amdgcn_readfirstlane(tid >> 6), lane = tid & 63, r = lane & 31, hh = lane >> 5;
    constexpr int KST = 400, VST = 136, KBUF = 64 * KST, VBUF = 128 * VST, VOFF = 2 * KBUF;
    static_assert(VOFF + 2 * VBUF <= LDS_BYTES, "lds");
    const int nit = (int)blockIdx.x < 512 ? ((511 - (int)blockIdx.x) / (int)gridDim.x + 1) * 2 : 0;
#define ATT_DECODE(it_, B_, H_, QB_) do { const int pi_ = (int)blockIdx.x + ((it_) >> 1) * (int)gridDim.x, pl_ = pi_ & 255, bh_ = (pi_ >> 8) * 64 + (pl_ & 7) * 8 + ((pl_ >> 3) >> 2), jp_ = (pl_ >> 3) & 3; \
        QB_ = ((it_) & 1) ? jp_ : 7 - jp_; B_ = bh_ >> 4; H_ = bh_ & 15; } while (0)
    bf16x8 qf[12];
    u32x4 kreg[3], vreg[2];
    const bf16_t* knsrc; const bf16_t* krsrc; const bf16_t* vtsrc;
    int tv = tid, rr = r, h2 = hh;
    asm volatile("" : "+v"(tv), "+v"(rr), "+v"(h2));
#define ATT_SETPTR(B_, H_) do { const int skey_ = tv >> 3, sc8_ = tv & 7, sdv_ = tv >> 2, sc4_ = tv & 3; \
        knsrc = KN + (((size_t)(B_) * SEQ + skey_) * 16 + (H_)) * 128 + sc8_ * 8; krsrc = KR + ((size_t)(B_) * SEQ + skey_) * 64 + sc8_ * 8; \
        vtsrc = MVT + (size_t)((H_) * 128 + sdv_) * TH + (size_t)(B_) * SEQ + sc4_ * 8; } while (0)
#define ATT_QLOAD(B_, H_, QB_) do { const size_t tq_ = (size_t)(B_) * SEQ + (QB_) * 256 + 32 * wid + rr; \
        _Pragma("unroll") for (int kk = 0; kk < 12; ++kk) qf[kk] = *(const bf16x8*)(MQ + (tq_ * 16 + (H_)) * 192 + 16 * kk + 8 * h2); } while (0)
#define ATT_LOAD(kt) do { \
    kreg[0] = *(const u32x4*)(knsrc + (size_t)(kt) * 64 * 2048); kreg[1] = *(const u32x4*)(knsrc + (size_t)(kt) * 64 * 2048 + 64); \
    kreg[2] = *(const u32x4*)(krsrc + (size_t)(kt) * 64 * 64); \
    vreg[0] = *(const u32x4*)(vtsrc + (kt) * 64); vreg[1] = *(const u32x4*)(vtsrc + (kt) * 64 + 32); } while (0)
    int b = 0, h = 0, qb = 0;
    if (nit > 0) { ATT_DECODE(0, b, h, qb); ATT_SETPTR(b, h); ATT_QLOAD(b, h, qb); ATT_LOAD(0); }
    for (int it = 0; it < nit; ++it) {
        {
            const int nkt = 4 * (qb + 1);
            const int q0w = qb * 256 + 32 * wid;
            tv = tid; rr = r; h2 = hh;
            asm volatile("" : "+v"(tv), "+v"(rr), "+v"(h2));
            const size_t tokq = (size_t)b * SEQ + q0w + rr;
            const int skey = tv >> 3, sc8 = tv & 7, sdv = tv >> 2, sc4 = tv & 3;
            LAS unsigned char* kdst0 = lds + skey * KST;
            LAS unsigned char* vdst0 = lds + VOFF + sdv * VST + sc4 * 16;
#define ATT_STORE(buf) do { LAS unsigned char* kdst = kdst0 + (buf) * KBUF; LAS unsigned char* vdst = vdst0 + (buf) * VBUF; \
    *(LAS u32x4*)(kdst + sc8 * 16) = kreg[0]; *(LAS u32x4*)(kdst + 128 + sc8 * 16) = kreg[1]; *(LAS u32x4*)(kdst + 256 + sc8 * 16) = kreg[2]; \
    *(LAS u32x2*)(vdst) = (u32x2){vreg[0].x, vreg[0].y}; *(LAS u32x2*)(vdst + 8) = (u32x2){vreg[0].z, vreg[0].w}; \
    *(LAS u32x2*)(vdst + 64) = (u32x2){vreg[1].x, vreg[1].y}; *(LAS u32x2*)(vdst + 72) = (u32x2){vreg[1].z, vreg[1].w}; } while (0)
            __syncthreads();
            ATT_STORE(0);
            if (nkt > 1) ATT_LOAD(1);
            __syncthreads();
            f32x16 o[4];
#pragma unroll
            for (int d = 0; d < 4; ++d)
#pragma unroll
                for (int e = 0; e < 16; ++e) o[d][e] = 0.f;
            float mrun = -1e30f, lrun = 0.f;
            for (int kt = 0; kt < nkt; ++kt) {
                const int buf = kt & 1;
                if (64 * kt <= q0w + 31) {
                    f32x16 s[2];
#pragma unroll
                    for (int jt = 0; jt < 2; ++jt)
#pragma unroll
                        for (int e = 0; e < 16; ++e) s[jt][e] = 0.f;
                    {
                        bf16x8 kf[2][4];
                        const LAS unsigned char* kb = lds + buf * KBUF + r * KST + hh * 16;
#define ATT_KREAD(dst, g_) do { _Pragma("unroll") for (int u = 0; u < 4; ++u) dst[u] = *(const LAS bf16x8*)(kb + (32 * (u & 1)) * KST + (2 * (g_) + (u >> 1)) * 32); } while (0)
                        ATT_KREAD(kf[0], 0);
#pragma unroll
                        for (int gq = 0; gq < 6; ++gq) {
                            if (gq < 5) ATT_KREAD(kf[(gq + 1) & 1], gq + 1);
                            __builtin_amdgcn_sched_barrier(0);
                            __builtin_amdgcn_s_setprio(1);
#pragma unroll
                            for (int u = 0; u < 4; ++u) s[u & 1] = MFMA32(kf[gq & 1][u], qf[2 * gq + (u >> 1)], s[u & 1]);
                            __builtin_amdgcn_s_setprio(0);
                            __builtin_amdgcn_sched_barrier(0);
                        }
#undef ATT_KREAD
                    }
                    const bool diag = 64 * kt + 63 > q0w;
                    float mx = -1e30f;
#pragma unroll
                    for (int jt = 0; jt < 2; ++jt)
#pragma unroll
                        for (int e = 0; e < 16; ++e) {
                            if (diag) { const int key = 64 * kt + 32 * jt + (e & 3) + 8 * (e >> 2) + 4 * hh; if (key > q0w + r) s[jt][e] = -1e30f; }
                            mx = fmaxf(mx, s[jt][e]);
                        }
                    mx = fmaxf(mx, __shfl_xor(mx, 32));
                    if (__builtin_amdgcn_ballot_w64(mx > mrun + 8.0f) != 0ull) {
                        const float mnew = fmaxf(mrun, mx), alpha = fexp2(mrun - mnew);
                        mrun = mnew; lrun *= alpha;
#pragma unroll
                        for (int d = 0; d < 4; ++d)
#pragma unroll
                            for (int e = 0; e < 16; ++e) o[d][e] *= alpha;
                    }
                    float ls = 0.f;
#pragma unroll
                    for (int jt = 0; jt < 2; ++jt)
#pragma unroll
                        for (int e = 0; e < 16; ++e) { const float p = fexp2(s[jt][e] - mrun); s[jt][e] = p; ls += p; }
                    lrun += ls;
                    bf16x8 pf[2][2];
#pragma unroll
                    for (int jt = 0; jt < 2; ++jt) { pf[jt][0] = pack_step(s[jt], 0); pf[jt][1] = pack_step(s[jt], 1); }
                    {
                        bf16x8 vf[2][2];
                        const LAS unsigned char* vbp = lds + VOFF + buf * VBUF + r * VST + hh * 8;
#define ATT_VREAD(dst, g_) do { _Pragma("unroll") for (int u = 0; u < 2; ++u) { const LAS unsigned char* vp = vbp + (32 * ((g_) >> 1)) * VST + (2 * ((g_) & 1) + u) * 32; \
        const s16x4 lo = *(const LAS s16x4*)vp, hi = *(const LAS s16x4*)(vp + 16); dst[u] = __builtin_shufflevector(lo, hi, 0, 1, 2, 3, 4, 5, 6, 7); } } while (0)
                        ATT_VREAD(vf[0], 0);
#pragma unroll
                        for (int g8 = 0; g8 < 8; ++g8) {
                            if (g8 < 7) ATT_VREAD(vf[(g8 + 1) & 1], g8 + 1);
                            __builtin_amdgcn_sched_barrier(0);
                            __builtin_amdgcn_s_setprio(1);
#pragma unroll
                            for (int u = 0; u < 2; ++u) o[g8 >> 1] = MFMA32(vf[g8 & 1][u], pf[g8 & 1][u], o[g8 >> 1]);
                            __builtin_amdgcn_s_setprio(0);
                            __builtin_amdgcn_sched_barrier(0);
                        }
#undef ATT_VREAD
                    }
                }
                if (kt + 1 < nkt) ATT_STORE(buf ^ 1);
                if (kt + 2 < nkt) ATT_LOAD(kt + 2);
                __syncthreads();
            }
            int nb = b, nh = h, nqb = qb;
            if (it + 1 < nit) { ATT_DECODE(it + 1, nb, nh, nqb); ATT_SETPTR(nb, nh); ATT_QLOAD(nb, nh, nqb); ATT_LOAD(0); }
            lrun += __shfl_xor(lrun, 32);
            const float inv = 1.0f / lrun;
            u32x2 gt[4][4];
#pragma unroll
            for (int d = 0; d < 4; ++d)
#pragma unroll
                for (int g4 = 0; g4 < 4; ++g4) gt[d][g4] = *(const u32x2*)(G + tokq * 2048 + h * 128 + 32 * d + 8 * g4 + 4 * h2);
#pragma unroll
            for (int d = 0; d < 4; ++d)
#pragma unroll
                for (int g4 = 0; g4 < 4; ++g4) {
                    bf16_t* gp = G + tokq * 2048 + h * 128 + 32 * d + 8 * g4 + 4 * h2;
                    u32x2 w;
                    w.x = pk2(o[d][4 * g4 + 0] * inv * silu(bflo(gt[d][g4].x)), o[d][4 * g4 + 1] * inv * silu(bfhi(gt[d][g4].x)));
                    w.y = pk2(o[d][4 * g4 + 2] * inv * silu(bflo(gt[d][g4].y)), o[d][4 * g4 + 3] * inv * silu(bfhi(gt[d][g4].y)));
                    *(u32x2*)(gp + gdelta) = w;
                }
            b = nb; h = nh; qb = nqb;
        }
    }
#undef ATT_LOAD
#undef ATT_STORE
#undef ATT_DECODE
#undef ATT_SETPTR
#undef ATT_QLOAD
}

DI void scan_phase(LAS unsigned char* lds, const Params& P, int tid0, bool dry) {
    const size_t gdelta = dry ? (O_DUMMY - O_G) / 2 : 0;
    const int skip = dry ? SCAN_SKIP : 0;
    const bf16_t* RQ = (const bf16_t*)(P.ws + O_RQ); const bf16_t* RK = (const bf16_t*)(P.ws + O_RK);
    const bf16_t* VT = (const bf16_t*)(P.ws + O_RVT);
    bf16_t* G = (bf16_t*)(P.ws + O_G); float* SSQO = (float*)(P.ws + O_SSQO);
    const int tid = tid0, wid = __builtin_amdgcn_readfirstlane(tid >> 6), lane = tid & 63, r = lane & 31, hh = lane >> 5;
    constexpr int KS = 528, TS = 272, SLOT = 64 * KS, VTO = 2 * SLOT, VTB = 64 * TS, VDO = VTO + VTB, RST = 528, RIO = VDO + VTB, RIB = 64 * RST;
    static_assert(RIO + RIB <= LDS_BYTES, "lds");
    const int ib = wid < 4 ? wid : 7 - wid, vh = wid >> 2;
    const int dbw = wid & 3, vb = wid >> 2;
    const int trq = (lane & 15) >> 2, trp = lane & 3, trb = (lane >> 4) & 1;
    for (int it = blockIdx.x; it < 256; it += gridDim.x) {
        const int bhx = (it & 7) * 4 + ((it >> 3) >> 3), sl = (it >> 3) & 7, b = bhx >> 2, h = bhx & 3;
        const int v0 = h * 512 + sl * 64;
        const float lg2 = __builtin_log2f(1.0f - fexp2(-5.0f - (float)h));
        const float cdec = fexp2(128.0f * lg2);
        __syncthreads();
        { unsigned zu = 0u; asm volatile("" : "+v"(zu));
          for (int i = tid; i < RIB / 16; i += 512) *(LAS u32x4*)(lds + RIO + i * 16) = (u32x4){zu, zu, zu, zu}; }
        u32x4 stg[4], vstg[2];
#define SC_LOADK(n_, jh_) do { _Pragma("unroll") for (int i = 0; i < 4; ++i) { const int p = tv + 512 * i; \
        stg[i] = *(const u32x4*)(RK + ((size_t)b * SEQ + (n_) * 128 + (jh_) * 64 + (p >> 5)) * 1024 + h * 256 + (p & 31) * 8); } } while (0)
#define SC_STOREK(slot) do { _Pragma("unroll") for (int i = 0; i < 4; ++i) { const int p = tv + 512 * i; \
        *(LAS u32x4*)(lds + (slot) * SLOT + (p >> 5) * KS + (p & 31) * 16) = stg[i]; } } while (0)
#define SC_VLOAD(n_) do { _Pragma("unroll") for (int i = 0; i < 2; ++i) { const int p = tv + 512 * i, row = p >> 4, ch = p & 15; \
        vstg[i] = *(const u32x4*)(VT + (size_t)(v0 + row) * TH + (size_t)b * SEQ + (n_) * 128 + ch * 8); } } while (0)
#define SC_VSTORE() do { _Pragma("unroll") for (int i = 0; i < 2; ++i) { const int p = tv + 512 * i, row = p >> 4, ch = p & 15; \
        *(LAS u32x4*)(lds + VTO + row * TS + ch * 16) = vstg[i]; \
        u32x4 dv_; const float e0_ = (float)(127 - 8 * ch); \
        dv_.x = pk2(bflo(vstg[i].x) * fexp2((e0_ - 0.f) * lg2), bfhi(vstg[i].x) * fexp2((e0_ - 1.f) * lg2)); \
        dv_.y = pk2(bflo(vstg[i].y) * fexp2((e0_ - 2.f) * lg2), bfhi(vstg[i].y) * fexp2((e0_ - 3.f) * lg2)); \
        dv_.z = pk2(bflo(vstg[i].z) * fexp2((e0_ - 4.f) * lg2), bfhi(vstg[i].z) * fexp2((e0_ - 5.f) * lg2)); \
        dv_.w = pk2(bflo(vstg[i].w) * fexp2((e0_ - 6.f) * lg2), bfhi(vstg[i].w) * fexp2((e0_ - 7.f) * lg2)); \
        *(LAS u32x4*)(lds + VDO + row * TS + ch * 16) = dv_; } } while (0)
        int tv = tid, rr = r, h2 = hh;
        asm volatile("" : "+v"(tv), "+v"(rr), "+v"(h2));
        SC_LOADK(0, 0); SC_STOREK(0); SC_VLOAD(0); SC_VSTORE();
        __syncthreads();
        f32x16 X0, X1, oi;
        bf16x8 qa[8], qb[8];
#define SC_QLOAD(dst, n_, kh_) do { _Pragma("unroll") for (int kk = 0; kk < 8; ++kk) \
        dst[kk] = *(const bf16x8*)(RQ + (((((size_t)b * SEQ + (n_) * 128 + 32 * ib) >> 5) * 4 + h) * 16 + 8 * (kh_) + kk) * 512 + (h2 * 32 + rr) * 8); } while (0)
        SC_QLOAD(qa, 0, 0);
#pragma unroll
        for (int e = 0; e < 16; ++e) { X0[e] = 0.f; X1[e] = 0.f; oi[e] = 0.f; }
        for (int gs = 0; gs < 32; ++gs) {
            const int n = gs >> 1, s = gs & 1;
            const size_t tokb = (size_t)b * SEQ + n * 128;
            int iq = 32 * ib + r;
            tv = tid; rr = r; h2 = hh;
            asm volatile("" : "+v"(iq), "+v"(tv), "+v"(rr), "+v"(h2));
            if (s == 0) SC_LOADK(n, 1);
            else if (n < 15) { SC_LOADK(n + 1, 0); SC_VLOAD(n + 1); }
            {
                const bool needq = s == 0 || 2 <= ib;
                const bf16_t* qsrc = needq ? RQ + (((((size_t)b * SEQ + n * 128 + 32 * ib) >> 5) * 4 + h) * 16 + 8) * 512 : RQ;
#pragma unroll
                for (int kk = 0; kk < 8; ++kk) qb[kk] = *(const bf16x8*)(qsrc + (needq ? kk * 512 : 0) + (h2 * 32 + rr) * 8);
            }
            {
                const bool act = 2 * s <= ib, two = 2 * s + 1 <= ib;
                f32x16 st[2];
#pragma unroll
                for (int jj = 0; jj < 2; ++jj)
#pragma unroll
                    for (int e = 0; e < 16; ++e) st[jj][e] = 0.f;
                if (s == 0) {
#pragma unroll
                    for (int e = 0; e < 16; ++e) oi[e] = 0.f;
                }
                {
                    const LAS unsigned char* kb0 = lds + s * SLOT + r * KS + hh * 16;
                    const LAS unsigned char* rb0 = lds + RIO + (32 * vh + r) * RST + hh * 16;
#define SC_GROUPS(DO1, DOC) do { \
        _Pragma("unroll") for (int g8 = 0; g8 < 8; ++g8) { \
            bf16x8 fk0[2], fk1[2], fr[2]; \
            _Pragma("unroll") for (int u = 0; u < 2; ++u) { \
                fk0[u] = *(const LAS bf16x8*)(kb0 + (2 * g8 + u) * 32); \
                if (DO1) fk1[u] = *(const LAS bf16x8*)(kb0 + 32 * KS + (2 * g8 + u) * 32); \
                if (DOC) fr[u] = *(const LAS bf16x8*)(rb0 + (2 * g8 + u) * 32); } \
            __builtin_amdgcn_sched_barrier(0); \
            _Pragma("unroll") for (int u = 0; u < 2; ++u) { \
                const int ks = 2 * g8 + u; \
                const bf16x8 q = ks < 8 ? qa[ks & 7] : qb[ks & 7]; \
                st[0] = MFMA32(fk0[u], q, st[0]); \
                if (DO1) st[1] = MFMA32(fk1[u], q, st[1]); \
                if (DOC) oi = MFMA32(fr[u], q, oi); }        \
            __builtin_amdgcn_sched_barrier(0); } } while (0)
                    if (!(skip & 1)) {
                        if (s == 0) { if (two) SC_GROUPS(1, 1); else SC_GROUPS(0, 1); }
                        else if (two) SC_GROUPS(1, 0);
                        else if (act) SC_GROUPS(0, 0);
                    }
#undef SC_GROUPS
                }
                if (s == 0) {
                    const float qd = fexp2((float)(iq + 1) * lg2);
#pragma unroll
                    for (int e = 0; e < 16; ++e) oi[e] *= qd;
                }
                if (act) {
#pragma unroll
                    for (int jj = 0; jj < 2; ++jj)
                        if (jj == 0 || two) {
                            const int jt = 2 * s + jj;
#pragma unroll
                            for (int e = 0; e < 16; ++e) { const int j = 32 * jt + (e & 3) + 8 * (e >> 2) + 4 * h2;
                                st[jj][e] = j <= iq ? st[jj][e] * fexp2((float)(iq - j) * lg2) : 0.f; }
#pragma unroll
                            for (int si = 0; si < 2; ++si) {
                                const bf16x8 pf = pack_step(st[jj], si);
                                const LAS unsigned char* vp = lds + VTO + (32 * vh + r) * TS + (32 * jt + 16 * si + 4 * hh) * 2;
                                const s16x4 lo = *(const LAS s16x4*)vp, hi = *(const LAS s16x4*)(vp + 16);
                                const bf16x8 vf = __builtin_shufflevector(lo, hi, 0, 1, 2, 3, 4, 5, 6, 7);
                                oi = MFMA32(vf, pf, oi);
                            }
                        }
                }
            }
            if (s == 0) {
                SC_STOREK(1);
                __syncthreads();
            } else {
                if (!(skip & 8)) {
                    float ss = 0.f;
#pragma unroll
                    for (int e = 0; e < 16; ++e) ss += oi[e] * oi[e];
                    ss += __shfl_xor(ss, 32);
                    const size_t tok = tokb + iq;
                    if (h2 == 0) SSQO[(tok * 4 + h) * 16 + sl * 2 + vh] = ss;
                    u32x2 gts[4];
#pragma unroll
                    for (int g4 = 0; g4 < 4; ++g4) gts[g4] = *(const u32x2*)(G + tok * 2048 + v0 + 32 * vh + 8 * g4 + 4 * h2);
#pragma unroll
                    for (int g4 = 0; g4 < 4; ++g4) {
                        bf16_t* gp = G + tok * 2048 + v0 + 32 * vh + 8 * g4 + 4 * h2;
                        const u32x2 gt = gts[g4];
                        u32x2 w;
                        w.x = pk2(oi[4 * g4 + 0] * silu(bflo(gt.x)), oi[4 * g4 + 1] * silu(bfhi(gt.x)));
                        w.y = pk2(oi[4 * g4 + 2] * silu(bflo(gt.y)), oi[4 * g4 + 3] * silu(bfhi(gt.y)));
                        *(u32x2*)(gp + gdelta) = w;
                    }
                }
                if (n < 15 && !(skip & 4)) {
                    SC_QLOAD(qa, n + 1, 0);
#pragma unroll
                    for (int e = 0; e < 16; ++e) { X0[e] *= cdec; X1[e] *= cdec; }
#pragma unroll
                    for (int kk = 0; kk < 8; ++kk) {
                        const LAS unsigned char* kp = lds + (kk >> 2) * SLOT + (16 * (kk & 3) + 8 * hh + trq) * KS + (32 * dbw + 16 * trb + 4 * trp) * 2;
                        const s16x4 t0 = __builtin_amdgcn_ds_read_tr16_b64_v4i16((LAS s16x4*)kp);
                        const s16x4 t1 = __builtin_amdgcn_ds_read_tr16_b64_v4i16((LAS s16x4*)(kp + 4 * KS));
                        const s16x4 t2 = __builtin_amdgcn_ds_read_tr16_b64_v4i16((LAS s16x4*)(kp + 256));
                        const s16x4 t3 = __builtin_amdgcn_ds_read_tr16_b64_v4i16((LAS s16x4*)(kp + 256 + 4 * KS));
                        const bf16x8 af0 = __builtin_shufflevector(t0, t1, 0, 1, 2, 3, 4, 5, 6, 7), af1 = __builtin_shufflevector(t2, t3, 0, 1, 2, 3, 4, 5, 6, 7);
                        const bf16x8 bf = *(const LAS bf16x8*)(lds + VDO + (32 * vb + r) * TS + (16 * kk + 8 * hh) * 2);
                        X0 = MFMA32(af0, bf, X0);
                        X1 = MFMA32(af1, bf, X1);
                    }
#pragma unroll
                    for (int g4 = 0; g4 < 4; ++g4) {
                        u32x2 w0, w1; w0.x = pk2(X0[4 * g4 + 0], X0[4 * g4 + 1]); w0.y = pk2(X0[4 * g4 + 2], X0[4 * g4 + 3]);
                        w1.x = pk2(X1[4 * g4 + 0], X1[4 * g4 + 1]); w1.y = pk2(X1[4 * g4 + 2], X1[4 * g4 + 3]);
                        *(LAS u32x2*)(lds + RIO + (32 * vb + r) * RST + (32 * dbw + 8 * g4 + 4 * hh) * 2) = w0;
                        *(LAS u32x2*)(lds + RIO + (32 * vb + r) * RST + (128 + 32 * dbw + 8 * g4 + 4 * hh) * 2) = w1;
                    }
                }
                __syncthreads();
                if (n < 15) { SC_STOREK(0); SC_VSTORE(); }
                __syncthreads();
            }
        }
#undef SC_LOADK
#undef SC_STOREK
#undef SC_VLOAD
#undef SC_VSTORE
#undef SC_QLOAD
    }
}

#define XB_TMO      128
#define XB_XCNT(j)  (256  + 64 * (j))
#define XB_XSUB(j)  (1280 + 64 * (j))
#define XB_XGEN(j)  (2304 + 64 * (j))
#define XB_TOP      3328
#define XB_TOPGEN   3392
#define XCD_BAR_WORDS 3456
#define XB_SPIN_CAP (1u << 18)
DI unsigned xb_ld(unsigned* p)              { return __hip_atomic_load(p, __ATOMIC_RELAXED, __HIP_MEMORY_SCOPE_AGENT); }
DI unsigned xb_add(unsigned* p, unsigned v) { return __hip_atomic_fetch_add(p, v, __ATOMIC_RELAXED, __HIP_MEMORY_SCOPE_AGENT); }
DI unsigned xb_xcc_id() { return (unsigned)__builtin_amdgcn_s_getreg((3 << 11) | 20) & 0xFu; }
#define XB_SPIN(cond, bar) do { while (cond) __builtin_amdgcn_s_sleep(1); } while (0)
DI void xcd_barrier_complete(unsigned* bar, unsigned x, unsigned& nloc, unsigned& nx) {
    const unsigned G = gridDim.x;
    unsigned sum, cnt, mine;
    for (;;) {
        sum = 0u; cnt = 0u; mine = 0u;
#pragma unroll
        for (unsigned j = 0; j < 16; ++j) { const unsigned c = xb_ld(&bar[XB_XCNT(j)]); sum += c; cnt += (c > 0u) ? 1u : 0u; mine = (j == x) ? c : mine; }
        if (sum == G) break;
        __builtin_amdgcn_s_sleep(1);
    }
    nloc = mine > 0u ? mine : 1u; nx = cnt > 0u ? cnt : 1u;
}
DI void xcd_barrier(unsigned* bar, unsigned x, volatile LAS unsigned* st, bool leader_thread) {
    asm volatile("s_waitcnt vmcnt(0)" ::: "memory");
    __syncthreads();
    if (leader_thread) {
        __builtin_amdgcn_s_waitcnt(0);
        unsigned nloc = st[0], nx = st[1];
        if (nloc == 0u) { xcd_barrier_complete(bar, x, nloc, nx); st[0] = nloc; st[1] = nx; }
        const unsigned old = xb_add(&bar[XB_XSUB(x)], 1u);
        const unsigned gen = old / nloc;
        if (old + 1u == (gen + 1u) * nloc) {
            __builtin_amdgcn_fence(__ATOMIC_RELEASE, "agent");
            asm volatile("s_waitcnt vmcnt(0)" ::: "memory");
            const unsigned og = xb_add(&bar[XB_TOP], 1u);
            const unsigned tg = og / nx;
            if (og + 1u == (tg + 1u) * nx) xb_add(&bar[XB_TOPGEN], 1u);
            else XB_SPIN(xb_ld(&bar[XB_TOPGEN]) == tg, bar);
            __builtin_amdgcn_fence(__ATOMIC_ACQUIRE, "agent");
            xb_add(&bar[XB_XGEN(x)], 1u);
            asm volatile("s_waitcnt vmcnt(0)" ::: "memory");
        } else {
            XB_SPIN(xb_ld(&bar[XB_XGEN(x)]) == gen, bar);
            __builtin_amdgcn_fence(__ATOMIC_ACQUIRE, "agent");
            asm volatile("s_waitcnt vmcnt(0)" ::: "memory");
        }
    }
    __syncthreads();
}

constexpr int NPHASES = 37;

DI int phase_kind(int ph) {
    if (ph == 0) return 0;
    const int q = (ph - 1) % 18; if (q == 0) return 3; if (q == 17) return 0;
    const int l = (q - 1) >> 2, s = (q - 1) & 3;
    if ((l & 1) == 0) return s == 0 ? 1 : s == 1 ? 2 : s == 2 ? 3 : 4;
    return s == 0 ? 5 : s == 1 ? 6 : s == 2 ? 7 : 4;
}
DI void run_phase(LAS unsigned char* lds, const Params& P, int ph, int wave_s, bool dry) {
    int tid0;
    asm volatile("v_mbcnt_lo_u32_b32 %0, -1, 0\n\tv_mbcnt_hi_u32_b32 %0, -1, %0" : "=v"(tid0));
    tid0 += wave_s * 64;
    if (ph == 0) { wprep_phase(lds, P, tid0); xprep_phase(P, 0, tid0); return; }
    const int half = (ph - 1) / 18, q = (ph - 1) % 18;
    if (q == 0) return;
    if (q == 17) { final_phase(P, half, tid0, dry); if (half == 0 && !dry) xprep_phase(P, 1, tid0); return; }
    const int l = (q - 1) >> 2, s = (q - 1) & 3;
    unsigned char* ws = P.ws;
    const int* pos = P.pos + (size_t)half * TH;
    if ((l & 1) == 0) {
        const int li = l >> 1;
        unsigned char* wb = ws + W_RET + (size_t)li * 16 * MiB;
        if (s == 1) { if (EN_SCAN) scan_phase(lds, P, tid0, dry); return; }
        if (s == 2) { gnorm_phase(P, tid0, dry); return; }
        const int ng = s == 0 ? 2 : 1;
        for (int gi = 0; gi < ng; ++gi) {
            GemmD g{};
            g.pos = pos; g.ssq_in = (const float*)(ws + ((half == 1 && l == 0) ? O_SSQH2 : O_SSQH));
            if (s == 0 && gi == 0) {
                g.A = (const bf16_t*)(ws + O_HB); g.Bt = (const bf16_t*)wb; g.lda = 1024; g.ldb = 1024; g.K = 1024; g.nM = 64; g.nN = 16; g.bskip_from = 8; g.bskip_add = 8; g.epi = E_RETQG;
                g.o0 = (bf16_t*)(ws + O_RQ); g.o1 = (bf16_t*)(ws + O_RK); g.o2 = (bf16_t*)(ws + O_G);
            } else if (s == 0) {
                g.A = (const bf16_t*)wb + (size_t)2048 * 1024; g.Bt = (const bf16_t*)(ws + O_HB); g.lda = 1024; g.ldb = 1024; g.K = 1024; g.nM = 8; g.nN = 64; g.bskip_from = 1 << 30; g.epi = E_VB;
                g.o1 = (bf16_t*)(ws + O_RVT); g.lg2a = 1.0f;
            } else {
                g.A = (const bf16_t*)(ws + O_G); g.Bt = (const bf16_t*)(wb + 12 * MiB); g.lda = 2048; g.ldb = 2048; g.K = 2048; g.nM = 64; g.nN = 4; g.bskip_from = 1 << 30; g.epi = E_OUT;
                g.kscale = (const float*)(ws + O_SSQO);
                g.hin = (l == 0 ? P.x : P.out) + (size_t)half * TH * DM; g.hout = P.out + (size_t)half * TH * DM;
                g.o0 = (bf16_t*)(ws + O_HB); g.ssq_out = (float*)(ws + O_SSQH);
                if (dry) { g.hout = (float*)(ws + O_DUMMY); g.o0 = (bf16_t*)(ws + O_DUMMY + 64 * MiB); g.ssq_out = (float*)(ws + O_DUMMY + 96 * MiB); }
            }
            if (EN_GEMM) gemm_phase(lds, g, tid0);
        }
    } else {
        const int li = l >> 1;
        unsigned char* wb = ws + W_MLA + (size_t)li * W_MLA_SZ;
        if (s == 2) { if (EN_ATTN) attn_phase(lds, P, tid0, dry); return; }
        const int ng = s == 1 ? 3 : 1;
        for (int gi = 0; gi < ng; ++gi) {
            GemmD g{};
            g.pos = pos; g.bskip_from = 1 << 30;
            if (s == 0) {
                g.A = (const bf16_t*)(ws + O_HB); g.Bt = (const bf16_t*)wb; g.lda = 1024; g.ldb = 1024; g.K = 1024; g.nM = 64; g.nN = 10; g.epi = E_MLAIN;
                g.ssq_in = (const float*)(ws + O_SSQH); g.o0 = (bf16_t*)(ws + O_LAT); g.o1 = (bf16_t*)(ws + O_KROPE); g.o2 = (bf16_t*)(ws + O_G);
                g.ssq_out = (float*)(ws + O_SSQQ); g.ssq_out2 = (float*)(ws + O_SSQKV);
            } else if (s == 1 && gi == 0) {
                g.A = (const bf16_t*)(ws + O_LAT); g.Bt = (const bf16_t*)(wb + 5 * MiB); g.lda = 384; g.ldb = 256; g.K = 256; g.nM = 64; g.nN = 12; g.epi = E_QB;
                g.ssq_in = (const float*)(ws + O_SSQQ); g.o0 = (bf16_t*)(ws + O_MQ);
            } else if (s == 1 && gi == 1) {
                g.A = (const bf16_t*)(ws + O_LAT) + 256; g.Bt = (const bf16_t*)(wb + 6 * MiB + MiB / 2); g.lda = 384; g.ldb = 128; g.K = 128; g.nM = 64; g.nN = 8; g.epi = E_KB;
                g.ssq_in = (const float*)(ws + O_SSQKV); g.o0 = (bf16_t*)(ws + O_KN);
            } else if (s == 1) {
                g.A = (const bf16_t*)(wb + 7 * MiB + MiB / 2); g.Bt = (const bf16_t*)(ws + O_LAT) + 256; g.lda = 128; g.ldb = 384; g.K = 128; g.nM = 8; g.nN = 64; g.epi = E_VB;
                g.ssq_in = (const float*)(ws + O_SSQKV); g.o1 = (bf16_t*)(ws + O_MVT);
            } else {
                g.A = (const bf16_t*)(ws + O_G); g.Bt = (const bf16_t*)(wb + 8 * MiB + MiB / 2); g.lda = 2048; g.ldb = 2048; g.K = 2048; g.nM = 64; g.nN = 4; g.epi = E_OUT;
                g.hin = P.out + (size_t)half * TH * DM; g.hout = P.out + (size_t)half * TH * DM;
                g.o0 = l == 3 ? nullptr : (bf16_t*)(ws + O_HB); g.ssq_out = (float*)(ws + O_SSQH);
                if (dry) { g.hout = (float*)(ws + O_DUMMY); g.o0 = (bf16_t*)(ws + O_DUMMY + 64 * MiB); g.ssq_out = (float*)(ws + O_DUMMY + 96 * MiB); }
            }
            if (EN_GEMM) gemm_phase(lds, g, tid0);
        }
    }
}

__global__ void __launch_bounds__(512, 2) trunk_megakernel(Params P) {
    extern __shared__ __attribute__((aligned(16))) unsigned char shm[];
    LAS unsigned char* lds = (LAS unsigned char*)shm;
    cg::grid_group grid = cg::this_grid();
    const int wave_s = __builtin_amdgcn_readfirstlane((int)(threadIdx.x >> 6));
    volatile LAS unsigned* st = (volatile LAS unsigned*)(lds + LDS_BYTES);
    unsigned* bar = (unsigned*)(P.ws + O_BAR);
    const unsigned xcc = xb_xcc_id();
    const bool use_xb = P.ph_hi - P.ph_lo > 1;
    if (use_xb) {
        if (threadIdx.x == 0) { st[0] = 0u; st[1] = 0u; (void)xb_add(&bar[XB_XCNT(xcc)], 1u); }
        __syncthreads();
    }
    const int ph_hi = __builtin_amdgcn_readfirstlane(P.ph_hi), ph_lo = __builtin_amdgcn_readfirstlane(P.ph_lo);
    int ph = ph_lo;
    if (ph < ph_hi) for (;;) {
        int nrep = (PROBE_DUP && ((PROBE_DUP >> phase_kind(ph)) & 2)) ? 2 : 1;
        if (phase_kind(ph) == 3) nrep = 0;
        if (nrep > 0) for (;;) {
            --nrep;
            run_phase(lds, P, ph, wave_s, nrep > 0);
            if (nrep > 0 || ph + 1 < ph_hi) {
                if (ph_lo < 0) grid.sync();
                else {
                    int l0; asm volatile("v_mbcnt_lo_u32_b32 %0, -1, 0\n\tv_mbcnt_hi_u32_b32 %0, -1, %0" : "=v"(l0));
                    for (int k = 0; k < 1 + (PROBE_DUP & 1); ++k) xcd_barrier(bar, xcc, st, wave_s == 0 && l0 == 0);
                }
            }
            nrep = __builtin_amdgcn_readfirstlane(nrep);
            if (nrep <= 0) break;
        }
        ph = __builtin_amdgcn_readfirstlane(ph + 1);
        if (ph >= ph_hi) break;
    }
}

extern "C" void kernel_launch(void* const* d_in, const int* in_sizes, int n_in, void* d_out, int out_size, void* d_ws, size_t ws_size, hipStream_t stream) {
    static int grid_blocks = 0;
    if (grid_blocks == 0) {
        if (n_in != 25 || ws_size < WS_NEED) { fprintf(stderr, "kernel_launch: unexpected n_in %d / ws %zu\n", n_in, ws_size); grid_blocks = -1; return; }
        int dev = 0, cus = 0, per_cu = 0;
        hipGetDevice(&dev);
        hipDeviceGetAttribute(&cus, hipDeviceAttributeMultiprocessorCount, dev);
        if (hipFuncSetAttribute((const void*)trunk_megakernel, hipFuncAttributeMaxDynamicSharedMemorySize, LDS_BYTES + 16) != hipSuccess) { fprintf(stderr, "hipFuncSetAttribute failed\n"); grid_blocks = -1; return; }
        hipOccupancyMaxActiveBlocksPerMultiprocessor(&per_cu, (const void*)trunk_megakernel, 512, LDS_BYTES + 16);
        if (per_cu < 1) per_cu = 1;
        if (per_cu > 1) per_cu = 1;
        grid_blocks = cus * per_cu;
        (void)hipGetLastError();
    }
    if (grid_blocks < 0) return;
    Params p{};
    p.x = (const float*)d_in[0]; p.pos = (const int*)d_in[1];
    p.lnorm[0] = (const float*)d_in[2]; p.ret_win[0] = (const float*)d_in[3]; p.ret_gn[0] = (const float*)d_in[4]; p.ret_wout[0] = (const float*)d_in[5];
    p.lnorm[1] = (const float*)d_in[6]; p.mla_win[0] = (const float*)d_in[7]; p.mla_qn[0] = (const float*)d_in[8]; p.mla_wqb[0] = (const float*)d_in[9];
    p.mla_kvn[0] = (const float*)d_in[10]; p.mla_wkvb[0] = (const float*)d_in[11]; p.mla_wout[0] = (const float*)d_in[12];
    p.lnorm[2] = (const float*)d_in[13]; p.ret_win[1] = (const float*)d_in[14]; p.ret_gn[1] = (const float*)d_in[15]; p.ret_wout[1] = (const float*)d_in[16];
    p.lnorm[3] = (const float*)d_in[17]; p.mla_win[1] = (const float*)d_in[18]; p.mla_qn[1] = (const float*)d_in[19]; p.mla_wqb[1] = (const float*)d_in[20];
    p.mla_kvn[1] = (const float*)d_in[21]; p.mla_wkvb[1] = (const float*)d_in[22]; p.mla_wout[1] = (const float*)d_in[23];
    p.fnorm = (const float*)d_in[24];
    p.out = (float*)d_out; p.ws = (unsigned char*)d_ws;
#if MULTI_LAUNCH
    for (int ph = 0; ph < NPHASES; ++ph) {
        p.ph_lo = ph; p.ph_hi = ph + 1;
        hipLaunchKernelGGL(trunk_megakernel, dim3(grid_blocks), dim3(512), LDS_BYTES + 16, stream, p);
    }
#else
    p.ph_lo = 0; p.ph_hi = NPHASES;
    if (hipMemsetAsync((char*)d_ws + O_BAR, 0, XCD_BAR_WORDS * 4, stream) != hipSuccess) { fprintf(stderr, "memset failed\n"); return; }
    void* args[] = {&p};
    hipError_t e = hipLaunchCooperativeKernel((const void*)trunk_megakernel, dim3(grid_blocks), dim3(512), args, LDS_BYTES + 16, stream);
    if (e != hipSuccess) fprintf(stderr, "cooperative launch failed: %s (grid %d)\n", hipGetErrorString(e), grid_blocks);
#endif
}
```
